# Optimizing an MI355X kernel written in HIP

```python
import jax, jax.numpy as jnp
from jax import lax
import numpy as np

D_MODEL = 4096
BATCH = 1
SEQ = 8192
DEPTH = 1
DEC_BATCH = 1
DEC_SEQ = 16384
PAST_LEN = 128

GRID_W = 64
EPS = 1e-6
HG_HEADS = 16
HG_DK = 128
HG_DV = 128
HG_WIDTH = HG_HEADS * HG_DK
HG_CHUNK = 64
ATT_Q_HEADS = 16
ATT_KV_HEADS = 4
HEAD_DIM = 128
ATT_WIDTH = ATT_Q_HEADS * HEAD_DIM
KV_WIDTH = ATT_KV_HEADS * HEAD_DIM
Q_BLOCK = 128
ROPE_THETA = 10000.0
ROPE_AXIS_DIM = HEAD_DIM // 2
D_FF = -(-8 * D_MODEL // (3 * 256)) * 256
IN_SIZES = (HG_WIDTH, HG_WIDTH, HG_WIDTH, HG_HEADS * HG_DV, HG_HEADS * HG_DV,
            ATT_WIDTH, KV_WIDTH, KV_WIDTH, D_MODEL, D_MODEL)
IN_WIDTH = sum(IN_SIZES)

kernel_name = 'hybrid_hgrn2_gqa_axial_encoder'


def rmsnorm(x, w):
    xf = x.astype(jnp.float32)
    xf = xf * lax.rsqrt(jnp.mean(xf * xf, axis=-1, keepdims=True) + EPS)
    return xf.astype(x.dtype) * w


def hgrn2_chunk_scan(q, k, v, log_f):
    B, T, H, DK = q.shape
    DV = v.shape[-1]
    n = T // HG_CHUNK

    def to_chunks(a):
        return a.reshape(B, n, HG_CHUNK, H, a.shape[-1]).transpose(1, 0, 3, 2, 4)

    xs = (to_chunks(q), to_chunks(k), to_chunks(v), to_chunks(log_f))
    causal = jnp.tril(jnp.ones((HG_CHUNK, HG_CHUNK), dtype=bool))[:, :, None]

    def step(S, inp):
        qi, ki, vi, gi = inp
        b = jnp.cumsum(gi, axis=-2)
        b_last = b[..., -1:, :]
        o_inter = jnp.einsum('bhtk,bhkv->bhtv', qi * jnp.exp(b), S)
        diff = b[..., :, None, :] - b[..., None, :, :]
        decay = jnp.exp(jnp.where(causal, diff, -jnp.inf))
        scores = jnp.einsum('bhtk,bhsk,bhtsk->bhts', qi, ki, decay)
        o_intra = jnp.einsum('bhts,bhsv->bhtv', scores, vi)
        S_new = jnp.exp(b_last[..., 0, :])[..., None] * S + jnp.einsum(
            'bhsk,bhsv->bhkv', ki * jnp.exp(b_last - b), vi)
        return S_new, o_inter + o_intra

    S0 = jnp.zeros((B, H, DK, DV), jnp.float32)
    _, o = lax.scan(step, S0, xs)
    return o.transpose(1, 0, 3, 2, 4).reshape(B, T, H, DV)


def forget_gate(z, lb):
    f = lb + (1.0 - lb) * jax.nn.sigmoid(z)
    return jnp.log(f), (1.0 - lb) * jax.nn.sigmoid(-z)


def hgrn2_bidirectional(q, z_fwd, z_bwd, i, lb_f, lb_b):
    q, z_fwd, z_bwd, i = (a.astype(jnp.float32) for a in (q, z_fwd, z_bwd, i))
    logf_f, k_f = forget_gate(z_fwd, lb_f)
    logf_b, k_b = forget_gate(z_bwd, lb_b)
    o_f = hgrn2_chunk_scan(q, k_f, i, logf_f)
    flip = lambda a: jnp.flip(a, axis=1)
    o_b = flip(hgrn2_chunk_scan(flip(q), flip(k_b), flip(i), flip(logf_b)))
    return o_f + o_b


def axial_rope_tables(T):
    rows = T // GRID_W
    row = jnp.repeat(jnp.arange(rows, dtype=jnp.float32), GRID_W)
    col = jnp.tile(jnp.arange(GRID_W, dtype=jnp.float32), rows)
    inv = ROPE_THETA ** (-jnp.arange(0, ROPE_AXIS_DIM, 2, dtype=jnp.float32) / ROPE_AXIS_DIM)
    ang = jnp.concatenate([row[:, None] * inv, col[:, None] * inv], axis=-1)
    return jnp.cos(ang), jnp.sin(ang)


def apply_axial_rope(x, cos, sin):
    xf = x.astype(jnp.float32).reshape(*x.shape[:-1], HEAD_DIM // 2, 2)
    x0, x1 = xf[..., 0], xf[..., 1]
    c, s = cos[None, :, None, :], sin[None, :, None, :]
    out = jnp.stack([x0 * c - x1 * s, x0 * s + x1 * c], axis=-1).reshape(x.shape)
    return out.astype(x.dtype)


def gqa_block_attention(q, k, v):
    B, T, Hq, D = q.shape
    G = Hq // ATT_KV_HEADS
    nb = T // Q_BLOCK
    scale = 1.0 / np.sqrt(HEAD_DIM).astype(np.float32)
    qb = q.reshape(B, nb, Q_BLOCK, ATT_KV_HEADS, G, D).transpose(1, 0, 2, 3, 4, 5)

    def block(qi):
        s = jnp.einsum('bqhgd,bkhd->bhgqk', qi, k).astype(jnp.float32) * scale
        p = jax.nn.softmax(s, axis=-1)
        return jnp.einsum('bhgqk,bkhd->bqhgd', p.astype(v.dtype), v)

    o = lax.map(block, qb)
    return o.transpose(1, 0, 2, 3, 4, 5).reshape(B, T, Hq * D)


def encoder_layer(x, norm_mix_w, w_in, lb_f, lb_b, hg_norm_w, q_norm_w, k_norm_w,
                  w_branch_a, w_branch_b, w_out, norm_ffn_w, w_gate_up, w_down):
    B, T, _ = x.shape
    h = rmsnorm(x, norm_mix_w)
    proj = h @ w_in
    splits = np.cumsum(IN_SIZES)[:-1].tolist()
    hq, hf_f, hf_b, hi, hog, aq, ak, av, ga, gb = jnp.split(proj, splits, axis=-1)

    heads = lambda a: a.reshape(B, T, HG_HEADS, -1)
    o_hg = hgrn2_bidirectional(heads(hq), heads(hf_f), heads(hf_b), heads(hi),
                               lb_f.reshape(HG_HEADS, HG_DK), lb_b.reshape(HG_HEADS, HG_DK))
    o_hg = rmsnorm(o_hg.astype(x.dtype), hg_norm_w.reshape(HG_HEADS, HG_DV))
    o_hg = (o_hg * jax.nn.silu(heads(hog))).reshape(B, T, HG_HEADS * HG_DV)
    y_a = o_hg @ w_branch_a

    cos, sin = axial_rope_tables(T)
    q = apply_axial_rope(rmsnorm(aq.reshape(B, T, ATT_Q_HEADS, HEAD_DIM), q_norm_w), cos, sin)
    k = apply_axial_rope(rmsnorm(ak.reshape(B, T, ATT_KV_HEADS, HEAD_DIM), k_norm_w), cos, sin)
    v = av.reshape(B, T, ATT_KV_HEADS, HEAD_DIM)
    y_b = gqa_block_attention(q, k, v) @ w_branch_b

    merged = jax.nn.sigmoid(ga) * y_a + jax.nn.sigmoid(gb) * y_b
    x = x + merged @ w_out

    gu = rmsnorm(x, norm_ffn_w) @ w_gate_up
    g, u = jnp.split(gu, 2, axis=-1)
    return x + (jax.nn.silu(g) * u) @ w_down


def trunk(x, norm_mix_w, w_in, lb_fwd, lb_bwd, hg_norm_w, q_norm_w, k_norm_w,
          w_branch_a, w_branch_b, w_out, norm_ffn_w, w_gate_up, w_down, norm_final_w):
    lbs_f = jnp.cumsum(jax.nn.softmax(lb_fwd.astype(jnp.float32), axis=0), axis=0)
    lbs_b = jnp.cumsum(jax.nn.softmax(lb_bwd.astype(jnp.float32), axis=0), axis=0)
    for l in range(DEPTH):
        x = encoder_layer(x, norm_mix_w[l], w_in[l], lbs_f[l], lbs_b[l], hg_norm_w[l],
                          q_norm_w[l], k_norm_w[l], w_branch_a[l], w_branch_b[l], w_out[l],
                          norm_ffn_w[l], w_gate_up[l], w_down[l])
    return rmsnorm(x, norm_final_w)


def setup_inputs(seed: int = 0) -> dict:
    key = jax.random.key(seed)
    ks = jax.random.split(key, 20)
    nrm = lambda k, shape, s: jax.random.normal(k, shape, jnp.float32) * s
    gain = lambda k, shape: 1.0 + 0.02 * jax.random.normal(k, shape, jnp.float32)
    return {
        'x_prompt': nrm(ks[0], (BATCH, SEQ, D_MODEL), 1.0),
        'x_sample': nrm(ks[1], (DEC_BATCH, DEC_SEQ, D_MODEL), 1.0),
        'norm_mix_w': gain(ks[2], (DEPTH, D_MODEL)),
        'w_in': nrm(ks[3], (DEPTH, D_MODEL, IN_WIDTH), D_MODEL ** -0.5),
        'lb_fwd': nrm(ks[4], (DEPTH + 1, HG_WIDTH), 0.5),
        'lb_bwd': nrm(ks[5], (DEPTH + 1, HG_WIDTH), 0.5),
        'hg_norm_w': gain(ks[6], (DEPTH, HG_HEADS * HG_DV)),
        'q_norm_w': gain(ks[7], (DEPTH, HEAD_DIM)),
        'k_norm_w': gain(ks[8], (DEPTH, HEAD_DIM)),
        'w_branch_a': nrm(ks[9], (DEPTH, HG_HEADS * HG_DV, D_MODEL), (HG_HEADS * HG_DV) ** -0.5),
        'w_branch_b': nrm(ks[10], (DEPTH, ATT_WIDTH, D_MODEL), ATT_WIDTH ** -0.5),
        'w_out': nrm(ks[11], (DEPTH, D_MODEL, D_MODEL), D_MODEL ** -0.5),
        'norm_ffn_w': gain(ks[12], (DEPTH, D_MODEL)),
        'w_gate_up': nrm(ks[13], (DEPTH, D_MODEL, 2 * D_FF), D_MODEL ** -0.5),
        'w_down': nrm(ks[14], (DEPTH, D_FF, D_MODEL), D_FF ** -0.5),
        'norm_final_w': gain(ks[15], (D_MODEL,)),
    }


def reference(x_prompt, x_sample, norm_mix_w, w_in, lb_fwd, lb_bwd, hg_norm_w, q_norm_w,
              k_norm_w, w_branch_a, w_branch_b, w_out, norm_ffn_w, w_gate_up, w_down,
              norm_final_w):
    y_prompt = trunk(x_prompt, norm_mix_w, w_in, lb_fwd, lb_bwd, hg_norm_w, q_norm_w, k_norm_w,
                     w_branch_a, w_branch_b, w_out, norm_ffn_w, w_gate_up, w_down, norm_final_w)
    y_sample = trunk(x_sample, norm_mix_w, w_in, lb_fwd, lb_bwd, hg_norm_w, q_norm_w, k_norm_w,
                     w_branch_a, w_branch_b, w_out, norm_ffn_w, w_gate_up, w_down, norm_final_w)
    return (y_prompt, y_sample)
```

```cpp
#include <hip/hip_runtime.h>
#include <cstdio>
#include <cstdint>
namespace pg8 {
#define PG8_LAS __attribute__((address_space(3)))
typedef unsigned short bf16_t;
typedef short bf16x8 __attribute__((ext_vector_type(8)));
typedef float f32x4 __attribute__((ext_vector_type(4)));
typedef unsigned u32x4 __attribute__((ext_vector_type(4)));
constexpr int BM = 256, BK = 64, HALF = 128, HTB = HALF * BK * 2  , STAGE_BYTES = 8 * HTB, NXCD = 8, WGM = 8;

__host__ __device__ __forceinline__ int lds_byte(int r, int c) { const int st = (r >> 4) * 2 + (c >> 5), rr = r & 15, cc = c & 31, ob = rr * 64 + cc * 2; return st * 1024 + (ob ^ (((ob >> 9) & 1) << 5)); }
__host__ __device__ __forceinline__ void stage_rc(int b, int& R, int& C) { const int st = b / 1024, sb = b % 1024, swz = sb ^ (((sb >> 9) & 1) << 5); R = (st >> 1) * 16 + swz / 64; C = (st & 1) * 32 + (swz % 64) / 2; }
__host__ __device__ __forceinline__ int perm32(int rho) { const int n = rho >> 4, i = rho & 15; return 8 * (i >> 2) + 4 * n + (i & 3); }

struct Unit { int pm, pn; };
struct Gemm { const bf16_t* A; const bf16_t* Bt; int M, N, K; };

struct StaticOrder {
    int nM, nN, nwg, G, c;
    __host__ __device__ void init(int M, int N, int G_, int c_) { nM = M / BM; nN = N / BM; nwg = nM * nN; G = G_; c = c_; }
    __host__ __device__ bool next(int i, Unit& u) const {
        const long L = (long)i * G + c; if (L >= nwg) return false;
        int wgid = (int)L; { const int q = nwg / NXCD, r = nwg % NXCD, xcd = wgid % NXCD, off = wgid / NXCD; wgid = (xcd < r ? xcd * (q + 1) : r * (q + 1) + (xcd - r) * q) + off; }
        const int nig = WGM * nN, gid = wgid / nig, fm = gid * WGM, gsz = (nM - fm) < WGM ? (nM - fm) : WGM;
        u.pm = fm + ((wgid % nig) % gsz); u.pn = (wgid % nig) / gsz; return true;
    }
    __device__ __forceinline__ void a_ready(const Unit&) const {}
    __device__ __forceinline__ void done(const Unit&) const {}
};
__device__ __forceinline__ unsigned cvt_pk_bf16(float lo, float hi) { unsigned r; asm volatile("v_cvt_pk_bf16_f32 %0, %1, %2" : "=v"(r) : "v"(lo), "v"(hi)); return r; }
typedef float f32x2 __attribute__((ext_vector_type(2)));
template <class Epi, class Sched, bool ALIGN_EPI = false, bool SP2 = false>
__device__ __forceinline__ void gemm_phase(PG8_LAS unsigned char* lds, const Gemm g, const Sched& S, const Epi& E) {
    const int tid = threadIdx.x, wid = __builtin_amdgcn_readfirstlane(tid >> 6), lane = tid & 63, wr = wid >> 2, wc = wid & 3, fr = lane & 15, fq = lane >> 4;
    const int K = g.K, nt = K / BK;
    unsigned voffA[2], voffB[2];
#pragma unroll
    for (int i = 0; i < 2; ++i) { int R, C; stage_rc(tid * 16 + i * 8192, R, C); const int Rb = Epi::PERM ? ((R & ~31) + perm32(R & 31)) : R;
        voffA[i] = (unsigned)(R * K + C) * 2u; voffB[i] = (unsigned)(Rb * K + C) * 2u; }
    const size_t kstep = (size_t)(BK * 2);
    const size_t hstep = (size_t)HALF * K * 2;
    const size_t tstep = 2 * hstep;
    const unsigned ldsw = (unsigned)wid * 1024u;
    const int aoff = lds_byte(wr * 64 + fr, fq * 8), boff = lds_byte(wc * 32 + fr, fq * 8);
#define PG8_SA(b, h) (((b) * 2 + (h)) * HTB)
#define PG8_SB(b, h) ((4 + (b) * 2 + (h)) * HTB)
#define PG8_STAGE(bufoff, gbase, voff) do { _Pragma("unroll") for (int _i = 0; _i < 2; ++_i) \
        __builtin_amdgcn_global_load_lds((const unsigned*)((const char*)(gbase) + (voff)[_i]), (PG8_LAS unsigned*)(lds + (bufoff) + ldsw + _i * 8192), 16, 0, 0); } while (0)
#define PG8_LDA(dst, b, h) do { _Pragma("unroll") for (int m = 0; m < 4; ++m) _Pragma("unroll") for (int k = 0; k < 2; ++k) dst[m][k] = *(const PG8_LAS bf16x8*)(lds + PG8_SA(b, h) + aoff + m * 2048 + k * 1024); } while (0)
#define PG8_LDB(dst, b, h) do { _Pragma("unroll") for (int n = 0; n < 2; ++n) _Pragma("unroll") for (int k = 0; k < 2; ++k) dst[n][k] = *(const PG8_LAS bf16x8*)(lds + PG8_SB(b, h) + boff + n * 2048 + k * 1024); } while (0)
#define PG8_MMA(ai, bj, At, Bt) do { __builtin_amdgcn_s_setprio(1); _Pragma("unroll") for (int m = 0; m < 4; ++m) _Pragma("unroll") for (int n = 0; n < 2; ++n) _Pragma("unroll") for (int k = 0; k < 2; ++k) \
        acc[ai][bj][m][n] = __builtin_amdgcn_mfma_f32_16x16x32_bf16(Bt[n][k], At[m][k], acc[ai][bj][m][n], 0, 0, 0); __builtin_amdgcn_s_setprio(0); } while (0)
#define PG8_WAIT_V(n) asm volatile("s_waitcnt vmcnt(" #n ")" ::: "memory")
#define PG8_WAIT_L(n) asm volatile("s_waitcnt lgkmcnt(" #n ")" ::: "memory")
#define PG8_BAR __builtin_amdgcn_s_barrier()
#define PG8_SCHED __builtin_amdgcn_sched_barrier(0)
    Unit cur, nxt; int ui = 0;
    if (!S.next(0, cur)) return;
    f32x4 acc[2][2][4][2];
#pragma unroll
    for (int a = 0; a < 2; ++a)
#pragma unroll
        for (int b = 0; b < 2; ++b)
#pragma unroll
            for (int m = 0; m < 4; ++m)
#pragma unroll
                for (int n = 0; n < 2; ++n) acc[a][b][m][n] = (f32x4){0.f, 0.f, 0.f, 0.f};
    bf16x8 At[4][2], B0[2][2], B1[2][2];
    const char* cA = (const char*)g.A + (size_t)cur.pm * tstep; const char* cB = (const char*)g.Bt + (size_t)cur.pn * tstep;
    S.a_ready(cur);
    if constexpr (SP2) {
        PG8_STAGE(PG8_SB(0, 0), cB, voffB); PG8_STAGE(PG8_SB(0, 1), cB + hstep, voffB); PG8_STAGE(PG8_SA(0, 0), cA, voffA); PG8_STAGE(PG8_SA(0, 1), cA + hstep, voffA);
        if (wr == 1) PG8_BAR;
        PG8_WAIT_V(2); PG8_BAR;
        PG8_STAGE(PG8_SB(1, 0), cB + kstep, voffB); PG8_STAGE(PG8_SA(1, 0), cA + kstep, voffA); PG8_STAGE(PG8_SB(1, 1), cB + hstep + kstep, voffB);
        PG8_WAIT_V(6); PG8_BAR;
    } else {
        PG8_STAGE(PG8_SB(0, 0), cB, voffB); PG8_STAGE(PG8_SA(0, 0), cA, voffA); PG8_STAGE(PG8_SB(0, 1), cB + hstep, voffB); PG8_STAGE(PG8_SA(0, 1), cA + hstep, voffA);
        if (wr == 1) PG8_BAR;
        PG8_WAIT_V(4); PG8_BAR;
        PG8_STAGE(PG8_SB(1, 0), cB + kstep, voffB); PG8_STAGE(PG8_SA(1, 0), cA + kstep, voffA); PG8_STAGE(PG8_SB(1, 1), cB + hstep + kstep, voffB);
        PG8_WAIT_V(6); PG8_BAR;
    }
    for (;;) {
        const bool has_next = S.next(ui + 1, nxt);
        const char* nA = has_next ? (const char*)g.A + (size_t)nxt.pm * tstep : cA; const char* nB = has_next ? (const char*)g.Bt + (size_t)nxt.pn * tstep : cB;
        for (int t = 0; t < nt; t += 2) {
            const bool last = (t == nt - 2);
            const char* a1 = cA + (size_t)(t + 1) * kstep;
            const char* a2 = last ? nA : cA + (size_t)(t + 2) * kstep; const char* b2 = last ? nB : cB + (size_t)(t + 2) * kstep;
            const char* a3 = a2 + kstep; const char* b3 = b2 + kstep;
            if (last && has_next) S.a_ready(nxt);
            if constexpr (SP2) {
            PG8_LDB(B0, 0, 0); PG8_LDB(B1, 0, 1); PG8_SCHED; PG8_LDA(At, 0, 0); PG8_STAGE(PG8_SA(1, 1), a1 + hstep, voffA);
            PG8_WAIT_V(8); PG8_WAIT_L(0); PG8_BAR; PG8_MMA(0, 0, At, B0); PG8_MMA(0, 1, At, B1); PG8_BAR; PG8_SCHED;
            PG8_LDA(At, 0, 1); PG8_STAGE(PG8_SB(0, 0), b2, voffB); PG8_STAGE(PG8_SB(0, 1), b2 + hstep, voffB); PG8_STAGE(PG8_SA(0, 0), a2, voffA);
            PG8_WAIT_V(8); PG8_WAIT_L(0); PG8_BAR; PG8_MMA(1, 0, At, B0); PG8_MMA(1, 1, At, B1); PG8_BAR; PG8_SCHED;
            PG8_LDB(B0, 1, 0); PG8_LDB(B1, 1, 1); PG8_SCHED; PG8_LDA(At, 1, 0); PG8_STAGE(PG8_SA(0, 1), a2 + hstep, voffA);
            PG8_WAIT_V(8); PG8_WAIT_L(0); PG8_BAR; PG8_MMA(0, 0, At, B0); PG8_MMA(0, 1, At, B1); PG8_BAR; PG8_SCHED;
            PG8_LDA(At, 1, 1); PG8_STAGE(PG8_SB(1, 0), b3, voffB); PG8_STAGE(PG8_SB(1, 1), b3 + hstep, voffB); PG8_STAGE(PG8_SA(1, 0), a3, voffA);
            PG8_WAIT_V(8); PG8_WAIT_L(0); PG8_BAR; PG8_MMA(1, 0, At, B0); PG8_MMA(1, 1, At, B1); PG8_BAR; PG8_SCHED;
            } else {
            PG8_LDB(B0, 0, 0); PG8_SCHED; PG8_LDA(At, 0, 0); PG8_STAGE(PG8_SA(1, 1), a1 + hstep, voffA);
            PG8_WAIT_L(8); PG8_BAR; PG8_WAIT_L(0); PG8_MMA(0, 0, At, B0); PG8_BAR; PG8_SCHED;
            PG8_LDB(B1, 0, 1); PG8_STAGE(PG8_SB(0, 0), b2, voffB);
            PG8_BAR; PG8_WAIT_L(0); PG8_MMA(0, 1, At, B1); PG8_BAR;
            PG8_LDA(At, 0, 1); PG8_STAGE(PG8_SA(0, 0), a2, voffA);
            PG8_BAR; PG8_WAIT_L(0); PG8_MMA(1, 0, At, B0); PG8_BAR; PG8_SCHED;
            PG8_STAGE(PG8_SB(0, 1), b2 + hstep, voffB);
            PG8_WAIT_V(6); PG8_BAR; PG8_MMA(1, 1, At, B1); PG8_BAR;
            PG8_LDB(B0, 1, 0); PG8_SCHED; PG8_LDA(At, 1, 0); PG8_STAGE(PG8_SA(0, 1), a2 + hstep, voffA);
            PG8_WAIT_L(8); PG8_BAR; PG8_WAIT_L(0); PG8_MMA(0, 0, At, B0); PG8_BAR; PG8_SCHED;
            PG8_LDB(B1, 1, 1); PG8_STAGE(PG8_SB(1, 0), b3, voffB);
            PG8_BAR; PG8_WAIT_L(0); PG8_MMA(0, 1, At, B1); PG8_BAR;
            PG8_LDA(At, 1, 1); PG8_STAGE(PG8_SA(1, 0), a3, voffA);
            PG8_BAR; PG8_WAIT_L(0); PG8_MMA(1, 0, At, B0); PG8_BAR; PG8_SCHED;
            PG8_STAGE(PG8_SB(1, 1), b3 + hstep, voffB);
            PG8_WAIT_V(6); PG8_BAR; PG8_MMA(1, 1, At, B1); PG8_BAR;
            }
        }
        if constexpr (ALIGN_EPI) { if (wr == 0) PG8_BAR; }
        if constexpr (!Epi::AFTER_DRAIN) { E(acc, cur, wr, wc, fr, fq); S.done(cur); }
        if (!has_next) break;
#pragma unroll
        for (int a = 0; a < 2; ++a)
#pragma unroll
            for (int b = 0; b < 2; ++b)
#pragma unroll
                for (int m = 0; m < 4; ++m)
#pragma unroll
                    for (int n = 0; n < 2; ++n) acc[a][b][m][n] = (f32x4){0.f, 0.f, 0.f, 0.f};
        cur = nxt; cA = nA; cB = nB; ++ui;
        if constexpr (ALIGN_EPI) { if (wr == 1) PG8_BAR; }
    }
    PG8_WAIT_V(0);
    if constexpr (!ALIGN_EPI) { if (wr == 0) PG8_BAR; }
    PG8_BAR;
    if constexpr (Epi::AFTER_DRAIN) { E.fused(acc, cur, wr, wc, fr, fq, lds, wid, lane); S.done(cur); }
#undef PG8_SA
#undef PG8_SB
#undef PG8_STAGE
#undef PG8_LDA
#undef PG8_LDB
#undef PG8_MMA
#undef PG8_WAIT_V
#undef PG8_WAIT_L
#undef PG8_BAR
#undef PG8_SCHED
}
}
#define GAS __attribute__((address_space(1)))
#define LAS __attribute__((address_space(3)))
typedef unsigned short bf16;
typedef unsigned v4u __attribute__((ext_vector_type(4)));
typedef float f32x4 __attribute__((ext_vector_type(4)));
typedef short bf16x8 __attribute__((ext_vector_type(8)));
typedef GAS unsigned gu32;
typedef GAS unsigned long long gu64;
#define RLX_AGENT __ATOMIC_RELAXED, __HIP_MEMORY_SCOPE_AGENT
#define LDS_WAIT() asm volatile("s_waitcnt lgkmcnt(0)" ::: "memory")
#define VM_WAIT() asm volatile("s_waitcnt vmcnt(0)" ::: "memory")
__device__ __forceinline__ unsigned long long rt() { return __builtin_amdgcn_s_memrealtime(); }
__device__ __forceinline__ unsigned f2bf(float f) { unsigned u = __builtin_bit_cast(unsigned, f); return (u + 0x7fffu + ((u >> 16) & 1u)) >> 16; }
__device__ __forceinline__ unsigned pk2(float lo, float hi) { return f2bf(lo) | (f2bf(hi) << 16); }
#define XB_TMO      128
#define XB_XCNT(j)  (256  + 64 * (j))
#define XB_XSUB(j)  (1280 + 64 * (j))
#define XB_XGEN(j)  (2304 + 64 * (j))
#define XB_TOP      3328
#define XB_TOPGEN   3392
#define XCD_BAR_WORDS 3456
#define XB_SPIN_CAP (1u << 22)

__device__ __forceinline__ unsigned xb_ld(unsigned* p)              { return __hip_atomic_load(p, __ATOMIC_RELAXED, __HIP_MEMORY_SCOPE_AGENT); }
__device__ __forceinline__ unsigned xb_add(unsigned* p, unsigned v) { return __hip_atomic_fetch_add(p, v, __ATOMIC_RELAXED, __HIP_MEMORY_SCOPE_AGENT); }
__device__ __forceinline__ unsigned xb_xcc_id() { return (unsigned)__builtin_amdgcn_s_getreg((3 << 11) | 20) & 0xFu; }
#define XB_SPIN(cond, bar) do { unsigned _sp = 0; while (cond) { __builtin_amdgcn_s_sleep(1); \
    if ((++_sp & 255u) == 0u) { if (xb_ld(&(bar)[XB_TMO])) break; if (_sp > XB_SPIN_CAP) { atomicAdd(&(bar)[XB_TMO], 1u); break; } } } } while (0)

struct XcdBarrier {
    unsigned* bar; unsigned x;
    volatile LAS unsigned* st;
};

__device__ __forceinline__ XcdBarrier xcd_barrier_post(unsigned* bar, volatile LAS unsigned* st) {
    XcdBarrier b; b.bar = bar; b.x = xb_xcc_id(); b.st = st;
    if (threadIdx.x == 0) (void)xb_add(&bar[XB_XCNT(b.x)], 1u);
    return b;
}
__device__ __forceinline__ void xcd_barrier_complete(unsigned* bar, unsigned x, unsigned& nloc, unsigned& nx) {
    const unsigned G = gridDim.x * gridDim.y * gridDim.z;
    unsigned sum, cnt, mine, sp = 0u;
    for (;;) {
        sum = 0u; cnt = 0u; mine = 0u;
#pragma unroll
        for (unsigned j = 0; j < 16; ++j) { const unsigned c = xb_ld(&bar[XB_XCNT(j)]); sum += c; cnt += (c > 0u) ? 1u : 0u; mine = (j == x) ? c : mine; }
        if (sum == G) break;
        __builtin_amdgcn_s_sleep(1);
        if ((++sp & 255u) == 0u) { if (xb_ld(&bar[XB_TMO])) break; if (sp > XB_SPIN_CAP) { atomicAdd(&bar[XB_TMO], 1u); break; } }
    }
    nloc = mine > 0u ? mine : 1u; nx = cnt > 0u ? cnt : 1u;
}

__device__ __forceinline__ void xcd_barrier(const XcdBarrier& b) {
    asm volatile("s_waitcnt vmcnt(0)" ::: "memory");
    __syncthreads();
    if (threadIdx.x == 0) {
        unsigned* bar = b.bar;
        __builtin_amdgcn_s_waitcnt(0);
        unsigned nloc = b.st[0], nx = b.st[1];
        if (nloc == 0u) { xcd_barrier_complete(bar, b.x, nloc, nx); b.st[0] = nloc; b.st[1] = nx; }
        const unsigned old = xb_add(&bar[XB_XSUB(b.x)], 1u);
        const unsigned gen = old / nloc;
        if (old + 1u == (gen + 1u) * nloc) {
            __builtin_amdgcn_fence(__ATOMIC_RELEASE, "agent");
            asm volatile("s_waitcnt vmcnt(0)" ::: "memory");
            const unsigned og = xb_add(&bar[XB_TOP], 1u);
            const unsigned tg = og / nx;
            if (og + 1u == (tg + 1u) * nx) xb_add(&bar[XB_TOPGEN], 1u);
            else XB_SPIN(xb_ld(&bar[XB_TOPGEN]) == tg, bar);
            __builtin_amdgcn_fence(__ATOMIC_ACQUIRE, "agent");
            xb_add(&bar[XB_XGEN(b.x)], 1u);
            asm volatile("s_waitcnt vmcnt(0)" ::: "memory");
        } else {
            XB_SPIN(xb_ld(&bar[XB_XGEN(b.x)]) == gen, bar);
            __builtin_amdgcn_fence(__ATOMIC_ACQUIRE, "agent");
            asm volatile("s_waitcnt vmcnt(0)" ::: "memory");
        }
    }
    __syncthreads();
}
__device__ __forceinline__ float wave_sum(float v) {
#pragma unroll
    for (int o = 1; o < 64; o <<= 1) v += __shfl_xor(v, o);
    return v;
}
__device__ __forceinline__ void p0_transpose_item(const float* W, int K, int N, bf16* WT, int row_off, LAS float* scr, int item, int lane) {
    const int nblk = N / 32, kb = item / nblk, nb = item % nblk, k0 = 64 * kb, n0 = 32 * nb;
#pragma unroll 8
    for (int i = 0; i < 32; ++i) { const int kk = 2 * i + (lane >> 5); scr[kk * 33 + (lane & 31)] = W[(size_t)(k0 + kk) * N + n0 + (lane & 31)]; }
    LDS_WAIT(); asm volatile("" ::: "memory");
    const int c = lane & 7;
#pragma unroll
    for (int j = 0; j < 4; ++j) { const int n = (lane >> 3) + 8 * j; const LAS float* s = scr + (8 * c) * 33 + n;
        v4u o; o.x = pk2(s[0 * 33], s[1 * 33]); o.y = pk2(s[2 * 33], s[3 * 33]); o.z = pk2(s[4 * 33], s[5 * 33]); o.w = pk2(s[6 * 33], s[7 * 33]);
        *(GAS v4u*)(WT + (size_t)(row_off + n0 + n) * K + k0 + 8 * c) = o; }
    LDS_WAIT(); asm volatile("" ::: "memory");
}

typedef unsigned short u16;
typedef float f32x2_t __attribute__((ext_vector_type(2)));
constexpr int NWAVES = 8;
constexpr int DM = 4096, T0 = 8192, T1 = 16384, M = T0 + T1;
constexpr int HGW = 2048, AW = 2048, KVW = 512, INW = 21504, DFF = 11008;
constexpr float EPS = 1e-6f;
constexpr size_t MiB = 1u << 20;
constexpr size_t WS_CTL = 0, CTL_ZERO_BYTES = 65536;
constexpr size_t WS_WA = 1 * MiB, WS_WB = 17 * MiB, WS_WOUT = 33 * MiB, WS_WGU = 65 * MiB, WS_WDN = 237 * MiB;
constexpr size_t WS_HQ = 323 * MiB, WS_ZF = 419 * MiB, WS_ZB = 515 * MiB, WS_HI = 611 * MiB, WS_HOG = 707 * MiB, WS_AQ = 803 * MiB;
constexpr size_t WS_AK = 899 * MiB, WS_AV = 923 * MiB, WS_GA = 947 * MiB, WS_GB = 1139 * MiB, WS_END = 1331 * MiB;
constexpr size_t WS_T = WS_ZF, WS_MERGED = WS_HI, WS_XN2 = WS_GA, WS_ACT = WS_HQ;
constexpr size_t DO_WIN = 0, DO_H = 168 * MiB, DO_OF = 0, DO_OB = 192 * MiB;
static_assert(WS_ACT + (size_t)M * DFF * 2 <= WS_AK && DO_H + (size_t)M * DM * 2 <= (size_t)M * DM * 4, "maps");
constexpr int CW_BAR = 4096;
constexpr int LDS_BYTES = 147456;
constexpr int MISC_OFF = 131072 + 320;

typedef _Float16 f16x2_t __attribute__((ext_vector_type(2)));
typedef _Float16 f16x8_t __attribute__((ext_vector_type(8)));
typedef unsigned u32x2_t __attribute__((ext_vector_type(2)));
typedef __bf16 bf16x2_t __attribute__((ext_vector_type(2)));
__device__ __forceinline__ unsigned pkbf(float lo, float hi) { f32x2_t v = {lo, hi}; bf16x2_t b = __builtin_convertvector(v, bf16x2_t); return __builtin_bit_cast(unsigned, b); }
__device__ __forceinline__ unsigned pkh(float lo, float hi) { f32x2_t v = {lo, hi}; f16x2_t h = __builtin_convertvector(v, f16x2_t); return __builtin_bit_cast(unsigned, h); }
__device__ __forceinline__ float bflo(unsigned w) { return __uint_as_float(w << 16); }
__device__ __forceinline__ float bfhi(unsigned w) { return __uint_as_float(w & 0xffff0000u); }
__device__ __forceinline__ float bf1(u16 h) { return __uint_as_float(((unsigned)h) << 16); }
__device__ __forceinline__ float sigm(float x) { return __builtin_amdgcn_rcpf(1.0f + __expf(-x)); }

template <int OP>
__device__ __forceinline__ void epi_store16(const pg8::f32x4 (&acc)[2][2][4][2], u16* base, int ldc, int row0, int col0) {
#pragma unroll
    for (int ai = 0; ai < 2; ++ai)
#pragma unroll
        for (int m = 0; m < 4; ++m) { u16* rowp = base + (size_t)(row0 + ai * 128 + m * 16) * ldc + col0;
#pragma unroll
            for (int bj = 0; bj < 2; ++bj) { pg8::f32x4 v0 = acc[ai][bj][m][0], v1 = acc[ai][bj][m][1];
                if (OP == 2) {
#pragma unroll
                    for (int e = 0; e < 4; ++e) { v0[e] = v0[e] * sigm(v0[e]); v1[e] = v1[e] * sigm(v1[e]); } }
                if (OP == 3) {
#pragma unroll
                    for (int e = 0; e < 4; ++e) { v0[e] = sigm(v0[e]); v1[e] = sigm(v1[e]); } }
                pg8::u32x4 w;
                if (OP == 1) { w.x = pkh(v0[0], v0[1]); w.y = pkh(v0[2], v0[3]); w.z = pkh(v1[0], v1[1]); w.w = pkh(v1[2], v1[3]); }
                else { w.x = pkbf(v0[0], v0[1]); w.y = pkbf(v0[2], v0[3]); w.z = pkbf(v1[0], v1[1]); w.w = pkbf(v1[2], v1[3]); }
                *(pg8::u32x4*)(rowp + bj * 128) = w; } }
}
struct EpiInProj {
    static constexpr bool PERM = true, AFTER_DRAIN = false;
    unsigned char* ws;
    __device__ __forceinline__ void operator()(const pg8::f32x4 (&acc)[2][2][4][2], const pg8::Unit& u, int wr, int wc, int fr, int fq) const {
        const int pn = u.pn, row0 = u.pm * 256 + wr * 64 + fr, cw = wc * 32 + 8 * fq;
        if (pn < 8)       epi_store16<0>(acc, (u16*)(ws + WS_HQ), HGW, row0, (pn - 0) * 256 + cw);
        else if (pn < 16) epi_store16<1>(acc, (u16*)(ws + WS_ZF), HGW, row0, (pn - 8) * 256 + cw);
        else if (pn < 24) epi_store16<1>(acc, (u16*)(ws + WS_ZB), HGW, row0, (pn - 16) * 256 + cw);
        else if (pn < 32) epi_store16<0>(acc, (u16*)(ws + WS_HI), HGW, row0, (pn - 24) * 256 + cw);
        else if (pn < 40) epi_store16<2>(acc, (u16*)(ws + WS_HOG), HGW, row0, (pn - 32) * 256 + cw);
        else if (pn < 48) epi_store16<0>(acc, (u16*)(ws + WS_AQ), AW, row0, (pn - 40) * 256 + cw);
        else if (pn < 50) epi_store16<0>(acc, (u16*)(ws + WS_AK), KVW, row0, (pn - 48) * 256 + cw);
        else if (pn < 52) epi_store16<0>(acc, (u16*)(ws + WS_AV), KVW, row0, (pn - 50) * 256 + cw);
        else if (pn < 68) epi_store16<3>(acc, (u16*)(ws + WS_GA), DM, row0, (pn - 52) * 256 + cw);
        else              epi_store16<3>(acc, (u16*)(ws + WS_GB), DM, row0, (pn - 68) * 256 + cw);
    }
};
template <bool ADD> struct EpiGate {
    static constexpr bool PERM = true, AFTER_DRAIN = false;
    const u16* sg; const u16* tin; u16* out;
    __device__ __forceinline__ void operator()(const pg8::f32x4 (&acc)[2][2][4][2], const pg8::Unit& u, int wr, int wc, int fr, int fq) const {
        const int row0 = u.pm * 256 + wr * 64 + fr, col0 = u.pn * 256 + wc * 32 + 8 * fq;
#pragma unroll
        for (int ai = 0; ai < 2; ++ai)
#pragma unroll
            for (int m = 0; m < 4; ++m) { const size_t off = (size_t)(row0 + ai * 128 + m * 16) * DM + col0;
#pragma unroll
                for (int bj = 0; bj < 2; ++bj) { const pg8::f32x4 v0 = acc[ai][bj][m][0], v1 = acc[ai][bj][m][1];
                    const pg8::u32x4 g = *(const pg8::u32x4*)(sg + off + bj * 128);
                    float r[8] = {bflo(g.x) * v0[0], bfhi(g.x) * v0[1], bflo(g.y) * v0[2], bfhi(g.y) * v0[3], bflo(g.z) * v1[0], bfhi(g.z) * v1[1], bflo(g.w) * v1[2], bfhi(g.w) * v1[3]};
                    if (ADD) { const pg8::u32x4 t = *(const pg8::u32x4*)(tin + off + bj * 128);
                        r[0] += bflo(t.x); r[1] += bfhi(t.x); r[2] += bflo(t.y); r[3] += bfhi(t.y); r[4] += bflo(t.z); r[5] += bfhi(t.z); r[6] += bflo(t.w); r[7] += bfhi(t.w); }
                    pg8::u32x4 w; w.x = pkbf(r[0], r[1]); w.y = pkbf(r[2], r[3]); w.z = pkbf(r[4], r[5]); w.w = pkbf(r[6], r[7]);
                    *(pg8::u32x4*)(out + off + bj * 128) = w; } }
    }
};
struct EpiResF32 {
    static constexpr bool PERM = true, AFTER_DRAIN = false;
    const float* base0; const float* base1; float* out;
    __device__ __forceinline__ void operator()(const pg8::f32x4 (&acc)[2][2][4][2], const pg8::Unit& u, int wr, int wc, int fr, int fq) const {
        const int col0 = u.pn * 256 + wc * 32 + 8 * fq;
        const int r0t = u.pm * 256;
        const float* bt = (r0t < T0) ? base0 + (size_t)r0t * DM : base1 + (size_t)(r0t - T0) * DM; float* ot = out + (size_t)r0t * DM;
#pragma unroll
        for (int ai = 0; ai < 2; ++ai)
#pragma unroll
            for (int m = 0; m < 4; ++m) { const int r = ai * 128 + wr * 64 + m * 16 + fr;
                const float* bs = bt + (size_t)r * DM + col0; float* op = ot + (size_t)r * DM + col0;
#pragma unroll
                for (int bj = 0; bj < 2; ++bj) {
                    pg8::f32x4 o0 = *(const pg8::f32x4*)(bs + bj * 128), o1 = *(const pg8::f32x4*)(bs + bj * 128 + 4);
#ifdef DBG_NOX
                    o0 = o0 * 0.0f; o1 = o1 * 0.0f;
#endif
                    o0 = o0 + acc[ai][bj][m][0]; o1 = o1 + acc[ai][bj][m][1];
                    *(pg8::f32x4*)(op + bj * 128) = o0; *(pg8::f32x4*)(op + bj * 128 + 4) = o1; } }
    }
};
struct EpiSwiGLU {
    static constexpr bool PERM = true, AFTER_DRAIN = false;
    u16* out;
    __device__ __forceinline__ void operator()(const pg8::f32x4 (&acc)[2][2][4][2], const pg8::Unit& u, int wr, int wc, int fr, int fq) const {
        const int row0 = u.pm * 256 + wr * 64 + fr, col0 = u.pn * 128 + wc * 32 + 8 * fq;
#pragma unroll
        for (int ai = 0; ai < 2; ++ai)
#pragma unroll
            for (int m = 0; m < 4; ++m) { const pg8::f32x4 g0 = acc[ai][0][m][0], g1 = acc[ai][0][m][1], u0 = acc[ai][1][m][0], u1 = acc[ai][1][m][1];
                float r[8];
#pragma unroll
                for (int e = 0; e < 4; ++e) { r[e] = g0[e] * sigm(g0[e]) * u0[e]; r[4 + e] = g1[e] * sigm(g1[e]) * u1[e]; }
                pg8::u32x4 w; w.x = pkbf(r[0], r[1]); w.y = pkbf(r[2], r[3]); w.z = pkbf(r[4], r[5]); w.w = pkbf(r[6], r[7]);
                *(pg8::u32x4*)(out + (size_t)(row0 + ai * 128 + m * 16) * DFF + col0) = w; }
    }
};

struct OneUnit {
    pg8::Unit u;
    __device__ __forceinline__ bool next(int i, pg8::Unit& o) const { if (i != 0) return false; o = u; return true; }
    __device__ __forceinline__ void a_ready(const pg8::Unit&) const {}
    __device__ __forceinline__ void done(const pg8::Unit&) const {}
};
template <class Epi> __device__ __forceinline__ void gemm_units(PG8_LAS unsigned char* lds, const pg8::Gemm g, const pg8::StaticOrder& S, const Epi& E) {
    pg8::Unit u;
    for (int i = 0; S.next(i, u); ++i) { OneUnit O{u}; pg8::gemm_phase<Epi, OneUnit, false, true>(lds, g, O, E); }
}

template <class Epi, class Sched>
__device__ __forceinline__ void gemm_rs(PG8_LAS unsigned char* lds, const pg8::Gemm g, const Sched& S, const Epi& E) {
    using pg8::HALF; using pg8::HTB; using pg8::BK; using pg8::bf16x8; using pg8::f32x4; using pg8::u32x4;
    const int tid = threadIdx.x, wid = __builtin_amdgcn_readfirstlane(tid >> 6), lane = tid & 63, wr = wid >> 2, wc = wid & 3, fr = lane & 15, fq = lane >> 4;
    const int K = g.K, nt = K / BK;
    unsigned voffA[2], voffB[2];
#pragma unroll
    for (int i = 0; i < 2; ++i) { int R, C; pg8::stage_rc(tid * 16 + i * 8192, R, C); const int Rb = Epi::PERM ? ((R & ~31) + pg8::perm32(R & 31)) : R;
        voffA[i] = (unsigned)(R * K + C) * 2u; voffB[i] = (unsigned)(Rb * K + C) * 2u; }
    const size_t kstep = (size_t)(BK * 2), hstep = (size_t)HALF * K * 2, tstep = 2 * hstep;
    const int aoff = pg8::lds_byte(wr * 64 + fr, fq * 8), boff = pg8::lds_byte(wc * 32 + fr, fq * 8);
    PG8_LAS unsigned char* wbase = lds + tid * 16;
#define RS_SA(b, h) (((b) * 2 + (h)) * HTB)
#define RS_SB(b, h) ((4 + (b) * 2 + (h)) * HTB)
#define RS_LOAD(t) do { const char* pa_ = cA + (size_t)(t) * kstep; const char* pb_ = cB + (size_t)(t) * kstep; _Pragma("unroll") for (int i_ = 0; i_ < 2; ++i_) { \
        rg[0 + i_] = *(const u32x4*)(pa_ + voffA[i_]); rg[2 + i_] = *(const u32x4*)(pa_ + hstep + voffA[i_]); rg[4 + i_] = *(const u32x4*)(pb_ + voffB[i_]); rg[6 + i_] = *(const u32x4*)(pb_ + hstep + voffB[i_]); } } while (0)
#define RS_WRITE(b) do { _Pragma("unroll") for (int i_ = 0; i_ < 2; ++i_) { *(PG8_LAS u32x4*)(wbase + RS_SA(b, 0) + i_ * 8192) = rg[0 + i_]; *(PG8_LAS u32x4*)(wbase + RS_SA(b, 1) + i_ * 8192) = rg[2 + i_]; \
        *(PG8_LAS u32x4*)(wbase + RS_SB(b, 0) + i_ * 8192) = rg[4 + i_]; *(PG8_LAS u32x4*)(wbase + RS_SB(b, 1) + i_ * 8192) = rg[6 + i_]; } } while (0)
#define RS_LDA(dst, b, h) do { _Pragma("unroll") for (int m = 0; m < 4; ++m) _Pragma("unroll") for (int k = 0; k < 2; ++k) dst[m][k] = *(const PG8_LAS bf16x8*)(lds + RS_SA(b, h) + aoff + m * 2048 + k * 1024); } while (0)
#define RS_LDB(dst, b, h) do { _Pragma("unroll") for (int n = 0; n < 2; ++n) _Pragma("unroll") for (int k = 0; k < 2; ++k) dst[n][k] = *(const PG8_LAS bf16x8*)(lds + RS_SB(b, h) + boff + n * 2048 + k * 1024); } while (0)
#define RS_MMA(ai, bj, At, Bt) do { _Pragma("unroll") for (int m = 0; m < 4; ++m) _Pragma("unroll") for (int n = 0; n < 2; ++n) _Pragma("unroll") for (int k = 0; k < 2; ++k) \
        acc[ai][bj][m][n] = __builtin_amdgcn_mfma_f32_16x16x32_bf16(Bt[n][k], At[m][k], acc[ai][bj][m][n], 0, 0, 0); } while (0)
#define RS_SEG() do { __builtin_amdgcn_sched_barrier(0); asm volatile("" ::: "memory"); } while (0)
#define RS_COMPUTE(b) do { bf16x8 At[4][2], Bt[2][2]; RS_SEG(); RS_LDA(At, b, 0); RS_LDB(Bt, b, 0); RS_MMA(0, 0, At, Bt); RS_SEG(); RS_LDB(Bt, b, 1); RS_MMA(0, 1, At, Bt); RS_SEG(); \
        RS_LDA(At, b, 1); RS_MMA(1, 1, At, Bt); RS_SEG(); RS_LDB(Bt, b, 0); RS_MMA(1, 0, At, Bt); RS_SEG(); } while (0)
    pg8::Unit u;
    for (int ui = 0; S.next(ui, u); ++ui) {
        f32x4 acc[2][2][4][2];
#pragma unroll
        for (int a = 0; a < 2; ++a)
#pragma unroll
            for (int b = 0; b < 2; ++b)
#pragma unroll
                for (int m = 0; m < 4; ++m)
#pragma unroll
                    for (int n = 0; n < 2; ++n) acc[a][b][m][n] = (f32x4){0.f, 0.f, 0.f, 0.f};
        const char* cA = (const char*)g.A + (size_t)u.pm * tstep; const char* cB = (const char*)g.Bt + (size_t)u.pn * tstep;
        u32x4 rg[8];
        RS_LOAD(0); RS_WRITE(0); RS_LOAD(1); __syncthreads();
        for (int t = 0; t < nt; t += 2) {
            RS_WRITE(1); if (t + 2 < nt) RS_LOAD(t + 2);
            RS_COMPUTE(0); __syncthreads();
            if (t + 2 < nt) { RS_WRITE(0); if (t + 3 < nt) RS_LOAD(t + 3); }
            RS_COMPUTE(1); __syncthreads();
        }
        E(acc, u, wr, wc, fr, fq);
    }
#undef RS_SA
#undef RS_SB
#undef RS_LOAD
#undef RS_WRITE
#undef RS_LDA
#undef RS_LDB
#undef RS_MMA
#undef RS_COMPUTE
#undef RS_SEG
}

namespace att {
using bf16x8 = __attribute__((ext_vector_type(8))) short;
using s16x4  = __attribute__((ext_vector_type(4))) short;
using f32x16 = __attribute__((ext_vector_type(16))) float;
using u32x4  = __attribute__((ext_vector_type(4))) unsigned;
using f32x4  = __attribute__((ext_vector_type(4))) float;
constexpr int   D = 128, NW = 8, QBLK = 32, KVBLK = 64, LDQ = 2048, LDK = 512;
constexpr float SCALE = 0.088388347648318440f;
constexpr float THR = 8.f;
constexpr size_t SHM_V = KVBLK * D * 2, SHM_K = KVBLK * D * 2, SHM_ATTN = 2 * SHM_V + 2 * SHM_K + NW * 64 * 4;
#define KSWZ(row, colB) ((row) * 256 + ((colB) ^ (((row) & 7) << 4)))
#define SBAR() __builtin_amdgcn_sched_barrier(0)
__device__ __forceinline__ int crow(int r, int hi) { return (r & 3) + 8 * (r >> 2) + 4 * hi; }
__device__ __forceinline__ unsigned cvtpk(float lo, float hi) { return pkbf(lo, hi); }
__device__ __forceinline__ void partialSM(f32x16& p0, f32x16& p1, float& m_reg, float& mn, float& alpha) {
  constexpr float C = SCALE * 1.4426950408889634f;
  float pmax = p0[0]; for (int r = 1; r < 16; ++r) pmax = fmaxf(pmax, p0[r]); for (int r = 0; r < 16; ++r) pmax = fmaxf(pmax, p1[r]);
  { auto rr = __builtin_amdgcn_permlane32_swap(__float_as_uint(pmax), __float_as_uint(pmax), false, false);
    pmax = fmaxf(__uint_as_float(rr[0]), __uint_as_float(rr[1])); }
  if (__builtin_expect(__all(pmax - m_reg <= THR / SCALE), 1)) { mn = m_reg; alpha = 1.f; }
  else { mn = fmaxf(m_reg, pmax); alpha = __builtin_amdgcn_exp2f((m_reg - mn) * C); m_reg = mn; }
  float mnC = -mn * C;
  for (int r = 0; r < 16; ++r) p0[r] = fmaf(p0[r], C, mnC); for (int r = 0; r < 16; ++r) p1[r] = fmaf(p1[r], C, mnC);
  for (int r = 0; r < 16; ++r) p0[r] = __builtin_amdgcn_exp2f(p0[r]);
}
__device__ __forceinline__ void finishSM(f32x16& p0, f32x16& p1, float alpha, float& l_reg, bf16x8& pa0, bf16x8& pa1, bf16x8& pa2, bf16x8& pa3) {
  for (int r = 0; r < 16; ++r) p1[r] = __builtin_amdgcn_exp2f(p1[r]);
  float ps = 0; for (int r = 0; r < 16; ++r) ps += p0[r]; for (int r = 0; r < 16; ++r) ps += p1[r];
  { auto rr = __builtin_amdgcn_permlane32_swap(__float_as_uint(ps), __float_as_uint(ps), false, false);
    ps = __uint_as_float(rr[0]) + __uint_as_float(rr[1]); }
  l_reg = l_reg * alpha + ps;
#define PK4(P, BASE, OUT) do { unsigned a0 = cvtpk(P[BASE + 0], P[BASE + 1]), a1 = cvtpk(P[BASE + 2], P[BASE + 3]);   \
    unsigned b0 = cvtpk(P[BASE + 4], P[BASE + 5]), b1 = cvtpk(P[BASE + 6], P[BASE + 7]);                              \
    auto r0 = __builtin_amdgcn_permlane32_swap(a0, b0, false, false); auto r1 = __builtin_amdgcn_permlane32_swap(a1, b1, false, false); \
    u32x4 w = {r0[0], r1[0], r0[1], r1[1]}; OUT = *reinterpret_cast<bf16x8*>(&w); } while (0)
  PK4(p0, 0, pa0); PK4(p0, 8, pa1); PK4(p1, 0, pa2); PK4(p1, 8, pa3);
#undef PK4
}
__device__ __forceinline__ void qkt(f32x16& p0, f32x16& p1, const u16* Ks, const bf16x8* qr, int r32, int hi) {
  p0 = f32x16{}; p1 = f32x16{};
  for (int d0 = 0; d0 < 8; ++d0) { int cb = (d0 * 16 + hi * 8) * 2;
    bf16x8 b0 = *reinterpret_cast<const bf16x8*>((const char*)Ks + KSWZ(r32, cb));
    bf16x8 b1 = *reinterpret_cast<const bf16x8*>((const char*)Ks + KSWZ(32 + r32, cb));
    p0 = __builtin_amdgcn_mfma_f32_32x32x16_bf16(b0, qr[d0], p0, 0, 0, 0);
    p1 = __builtin_amdgcn_mfma_f32_32x32x16_bf16(b1, qr[d0], p1, 0, 0, 0); }
}
__device__ __forceinline__ int v_st(int k, int c) { const int kk = (k & ~0xC) | ((k & 4) << 1) | ((k & 8) >> 1); return ((kk >> 3) * 4 + (c >> 5)) * 512 + ((kk & 7) * 32 + (c & 31)) * 2; }
__device__ __forceinline__ int v_rd_base(int lane) { return ((lane & 3) << 3) | (((lane >> 2) & 3) << 6) | (((lane >> 4) & 1) << 5) | (((lane >> 5) & 1) << 8); }
constexpr int v_rd_off(int d0, int ks, int half) { return d0 * 512 + ks * 4096 + half * 2048; }
template <int OFF> __device__ __forceinline__ s16x4 tr_read(int vb) {
  s16x4 r; asm volatile("ds_read_b64_tr_b16 %0, %1 offset:%2" : "=&v"(r) : "v"(vb), "i"(OFF) : "memory"); return r;
}
template <int D0> __device__ __forceinline__ void pv_one(f32x16& od, int vb, bf16x8 pa0, bf16x8 pa1, bf16x8 pa2, bf16x8 pa3) {
  const s16x4 l0 = tr_read<v_rd_off(D0, 0, 0)>(vb), h0 = tr_read<v_rd_off(D0, 0, 1)>(vb), l1 = tr_read<v_rd_off(D0, 1, 0)>(vb), h1 = tr_read<v_rd_off(D0, 1, 1)>(vb);
  const s16x4 l2 = tr_read<v_rd_off(D0, 2, 0)>(vb), h2 = tr_read<v_rd_off(D0, 2, 1)>(vb), l3 = tr_read<v_rd_off(D0, 3, 0)>(vb), h3 = tr_read<v_rd_off(D0, 3, 1)>(vb);
  asm volatile("s_waitcnt lgkmcnt(0)" ::: "memory"); SBAR();
#define PK(L, H) (bf16x8){L[0], L[1], L[2], L[3], H[0], H[1], H[2], H[3]}
  od = __builtin_amdgcn_mfma_f32_32x32x16_bf16(pa0, PK(l0, h0), od, 0, 0, 0);
  od = __builtin_amdgcn_mfma_f32_32x32x16_bf16(pa1, PK(l1, h1), od, 0, 0, 0);
  od = __builtin_amdgcn_mfma_f32_32x32x16_bf16(pa2, PK(l2, h2), od, 0, 0, 0);
  od = __builtin_amdgcn_mfma_f32_32x32x16_bf16(pa3, PK(l3, h3), od, 0, 0, 0);
#undef PK
}
__device__ __forceinline__ void pv_d0(f32x16* o, int vb, bf16x8 pa0, bf16x8 pa1, bf16x8 pa2, bf16x8 pa3) {
  pv_one<0>(o[0], vb, pa0, pa1, pa2, pa3); pv_one<1>(o[1], vb, pa0, pa1, pa2, pa3); pv_one<2>(o[2], vb, pa0, pa1, pa2, pa3); pv_one<3>(o[3], vb, pa0, pa1, pa2, pa3);
}
__device__ __forceinline__ void attn_unit(u16* Qb, const u16* __restrict__ Kh, const u16* __restrict__ Vh, const float* __restrict__ qnw, int pos0, int seq, char* lds) {
  int tid = threadIdx.x; asm volatile("" : "+v"(tid));
  const int wid = __builtin_amdgcn_readfirstlane(tid >> 6), lane = tid & 63, r32 = lane & 31, hi = lane >> 5;
  u16* V_lds = (u16*)lds; u16* K_lds = (u16*)(lds + 2 * SHM_V);
  float* ws = (float*)(lds + 2 * SHM_V + 2 * SHM_K) + wid * 64; float* li_l = ws; float* al_l = ws + 32;
  float m_reg = -1e30f, l_reg = 0; f32x16 o[4] = {}; bf16x8 qr[8];
  {
    int hl = hi; asm volatile("" : "+v"(hl));
    const u16* Qw = Qb + (long)(wid * QBLK + r32) * LDQ + hi * 8;
    u32x4 raw[8];
#pragma unroll
    for (int d0 = 0; d0 < 8; ++d0) raw[d0] = *reinterpret_cast<const u32x4*>(Qw + d0 * 16);
    float ss = 0.f;
#pragma unroll
    for (int d0 = 0; d0 < 8; ++d0)
#pragma unroll
      for (int e = 0; e < 4; ++e) { const float a = bflo(raw[d0][e]), b = bfhi(raw[d0][e]); ss += a * a + b * b; }
    { auto rr = __builtin_amdgcn_permlane32_swap(__float_as_uint(ss), __float_as_uint(ss), false, false); ss = __uint_as_float(rr[0]) + __uint_as_float(rr[1]); }
    const float rstd = 1.0f / sqrtf(ss * (1.0f / 128.0f) + EPS);
    const int pos = pos0 + wid * QBLK + r32; const float prow = (float)(pos >> 6), pcol = (float)(pos & 63);
#pragma unroll
    for (int d0 = 0; d0 < 8; ++d0) {
      const f32x4 w0 = *reinterpret_cast<const f32x4*>(qnw + d0 * 16 + hl * 8), w1 = *reinterpret_cast<const f32x4*>(qnw + d0 * 16 + hl * 8 + 4);
      const float wv[8] = {w0[0], w0[1], w0[2], w0[3], w1[0], w1[1], w1[2], w1[3]};
      u32x4 wq;
#pragma unroll
      for (int e = 0; e < 4; ++e) {
        const int fi = (d0 & 3) * 8 + hl * 4 + e;
        const float inv = exp2f(-(float)fi * 0.41524101186092029f);
        const float ang = (d0 < 4 ? prow : pcol) * inv; const float sn = __sinf(ang), cs = __cosf(ang);
        const float x0 = bflo(raw[d0][e]) * rstd * wv[2 * e], x1 = bfhi(raw[d0][e]) * rstd * wv[2 * e + 1];
        wq[e] = cvtpk(x0 * cs - x1 * sn, x0 * sn + x1 * cs); }
      qr[d0] = *reinterpret_cast<bf16x8*>(&wq); }
  }
  const int sr = tid >> 4, sc = (tid & 15) * 8, vst0 = v_st(sr, sc), vst1 = v_st(32 + sr, sc);
  const int vb0 = (int)(uintptr_t)V_lds + v_rd_base(lane);
  struct { bf16x8 vs0, vs1, ks0, ks1; } sr_[2];
#define ALD8(p) (*reinterpret_cast<const bf16x8*>(p))
  const int so0 = sr * LDK + sc, so1 = (32 + sr) * LDK + sc;
#define SLOAD(i, k0) do { const u16* vt_ = Vh + (size_t)(k0) * LDK; const u16* kt_ = Kh + (size_t)(k0) * LDK; sr_[i].vs0 = ALD8(vt_ + so0); sr_[i].vs1 = ALD8(vt_ + so1); \
    sr_[i].ks0 = ALD8(kt_ + so0); sr_[i].ks1 = ALD8(kt_ + so1); } while (0)
#define SWRITE(b, i) do { *(bf16x8*)((char*)V_lds + (b) * SHM_V + vst0) = sr_[i].vs0;          \
    *(bf16x8*)((char*)V_lds + (b) * SHM_V + vst1) = sr_[i].vs1; int kc = sc * 2;               \
    *(bf16x8*)((char*)K_lds + (b) * SHM_K + KSWZ(sr, kc)) = sr_[i].ks0;                       \
    *(bf16x8*)((char*)K_lds + (b) * SHM_K + KSWZ(32 + sr, kc)) = sr_[i].ks1; } while (0)
#define SWAIT() asm volatile("s_waitcnt vmcnt(4)" ::: "memory")
#define RESC(a) do { if (__any((a) < 1.f)) { if (hi == 0) al_l[r32] = (a); asm volatile("s_waitcnt lgkmcnt(0)" ::: "memory"); \
    for (int d = 0; d < 4; ++d) for (int r = 0; r < 16; ++r) o[d][r] *= al_l[crow(r, hi)]; } } while (0)
  f32x16 pA0, pA1, pB0, pB1; float mnA, mnB, alA, alB; bf16x8 pa0, pa1, pa2, pa3; const int NT = seq / KVBLK;
  constexpr int SE = 0, SO = 1;
  SLOAD(SE, 0); asm volatile("s_waitcnt vmcnt(0)" ::: "memory"); SWRITE(0, SE); __syncthreads();
  qkt(pA0, pA1, K_lds, qr, r32, hi); partialSM(pA0, pA1, m_reg, mnA, alA);
  SLOAD(SO, KVBLK); if (2 < NT) SLOAD(SE, 2 * KVBLK);
  SWAIT(); SWRITE(1, SO); __syncthreads();
  for (int j = 1; j + 1 < NT; j += 2) {
    SBAR(); qkt(pB0, pB1, (u16*)((char*)K_lds + SHM_K), qr, r32, hi);
    finishSM(pA0, pA1, alA, l_reg, pa0, pa1, pa2, pa3); SBAR();
    SLOAD(SO, (j + 2) * KVBLK); SBAR();
    pv_d0(o, vb0, pa0, pa1, pa2, pa3); partialSM(pB0, pB1, m_reg, mnB, alB);
    __syncthreads(); SWAIT(); SWRITE(0, SE);
    RESC(alB); __syncthreads();
    SBAR(); qkt(pA0, pA1, K_lds, qr, r32, hi);
    finishSM(pB0, pB1, alB, l_reg, pa0, pa1, pa2, pa3); SBAR();
    if (j + 3 < NT) SLOAD(SE, (j + 3) * KVBLK); SBAR();
    pv_d0(o, vb0 + (int)SHM_V, pa0, pa1, pa2, pa3); partialSM(pA0, pA1, m_reg, mnA, alA);
    __syncthreads(); SWAIT(); SWRITE(1, SO);
    RESC(alA); __syncthreads();
  }
  SBAR(); qkt(pB0, pB1, (u16*)((char*)K_lds + SHM_K), qr, r32, hi);
  finishSM(pA0, pA1, alA, l_reg, pa0, pa1, pa2, pa3); SBAR();
  pv_d0(o, vb0, pa0, pa1, pa2, pa3); partialSM(pB0, pB1, m_reg, mnB, alB);
  __syncthreads(); RESC(alB);
  finishSM(pB0, pB1, alB, l_reg, pa0, pa1, pa2, pa3); SBAR();
  pv_d0(o, vb0 + (int)SHM_V, pa0, pa1, pa2, pa3);
  if (hi == 0) li_l[r32] = l_reg; asm volatile("s_waitcnt lgkmcnt(0)" ::: "memory");
  float rli[16];
#pragma unroll
  for (int r = 0; r < 16; ++r) rli[r] = __builtin_amdgcn_rcpf(li_l[crow(r, hi)]);
  u16* Ow = Qb + (long)(wid * QBLK) * LDQ;
#pragma unroll
  for (int r = 0; r < 16; ++r) { const int oo = crow(r, hi) * LDQ + r32;
    for (int d0 = 0; d0 < 4; ++d0) Ow[oo + d0 * 32] = (u16)(cvtpk(o[d0][r] * rli[r], 0.f) & 0xffffu); }
  __syncthreads();
#undef ALD8
#undef SLOAD
#undef SWRITE
#undef SWAIT
#undef RESC
}
#undef KSWZ
#undef SBAR
}

__device__ __forceinline__ void tr_item(const float* W, int K, int N, u16* WT, LAS float* scr, int item, int lane, bool gu) {
    const int nblk = N / 32, kb = item / nblk, nb = item % nblk, k0 = 64 * kb, n0 = 32 * nb;
#pragma unroll 8
    for (int i = 0; i < 32; ++i) { const int kk = 2 * i + (lane >> 5); scr[kk * 33 + (lane & 31)] = W[(size_t)(k0 + kk) * N + n0 + (lane & 31)]; }
    LDS_WAIT(); asm volatile("" ::: "memory");
    int r0 = n0;
    if (gu) { const int isu = n0 >= DFF ? 1 : 0, nn = n0 - isu * DFF; r0 = (nn >> 7) * 256 + isu * 128 + (nn & 127); }
    const int c = lane & 7;
#pragma unroll
    for (int j = 0; j < 4; ++j) { const int n = (lane >> 3) + 8 * j; const LAS float* s = scr + (8 * c) * 33 + n;
        v4u o; o.x = pkbf(s[0 * 33], s[1 * 33]); o.y = pkbf(s[2 * 33], s[3 * 33]); o.z = pkbf(s[4 * 33], s[5 * 33]); o.w = pkbf(s[6 * 33], s[7 * 33]);
        *(GAS v4u*)(WT + (size_t)(r0 + n) * K + k0 + 8 * c) = o; }
    LDS_WAIT(); asm volatile("" ::: "memory");
}
__device__ __forceinline__ void rms_row(const float* xrow, const float* w, u16* ob, float* of, int lane) {
    const f32x4* xr = (const f32x4*)xrow + lane; const f32x4* wr = (const f32x4*)w + lane;
    f32x4 v[16]; float s = 0.f;
#pragma unroll
    for (int j = 0; j < 16; ++j) { v[j] = xr[64 * j]; s += (v[j].x * v[j].x + v[j].y * v[j].y) + (v[j].z * v[j].z + v[j].w * v[j].w); }
    const float rstd = 1.0f / sqrtf(wave_sum(s) * (1.0f / DM) + EPS);
#pragma unroll
    for (int j = 0; j < 16; ++j) { const f32x4 wv = wr[64 * j]; const f32x4 o = (v[j] * rstd) * wv;
        if (ob) { u32x2_t p; p.x = pkbf(o.x, o.y); p.y = pkbf(o.z, o.w); ((u32x2_t*)ob)[lane + 64 * j] = p; }
        else ((f32x4*)of)[lane + 64 * j] = o; }
}
__device__ __forceinline__ void k_norm_rope(u16* AK, const float* knw, int gw, int NGW, int lane) {
    const float inv = exp2f(-(float)(lane & 31) * 0.41524101186092029f);
    const float w0 = knw[2 * lane], w1 = knw[2 * lane + 1];
    for (int it = gw; it < M * 4; it += NGW) {
        const int m = it >> 2, kvh = it & 3; unsigned* p = (unsigned*)(AK + (size_t)m * KVW + kvh * 128) + lane;
        const unsigned raw = *p; const float a = bflo(raw), b = bfhi(raw);
        const float rstd = 1.0f / sqrtf(wave_sum(a * a + b * b) * (1.0f / 128.0f) + EPS);
        const int pos = m < T0 ? m : m - T0; const float ang = (lane < 32 ? (float)(pos >> 6) : (float)(pos & 63)) * inv;
        const float sn = __sinf(ang), cs = __cosf(ang), x0 = a * rstd * w0, x1 = b * rstd * w1;
        *p = pkbf(x0 * cs - x1 * sn, x0 * sn + x1 * cs);
    }
}
__device__ __forceinline__ void hgrn_scan_naive(const u16* HQ, const u16* ZF, const u16* ZB, const u16* HI, const float* lbf, const float* lbb, float* OF, float* OB, int vcu, int G, int tid) {
    const int kg = tid & 15, vl = tid >> 4;
    for (int item = vcu; item < 256; item += G) {
        const int vq = item & 3, chain = item >> 2, seq = (chain >> 5) ^ 1, dir = (chain >> 4) & 1, h = chain & 15;
        const int rowbase = seq ? T0 : 0, T = seq ? T1 : T0, kcol = h * 128 + kg * 8, vcol = h * 128 + vq * 32 + vl;
        const float* lbp = dir ? lbb : lbf; const u16* Z = dir ? ZB : ZF; float* O = dir ? OB : OF;
        float oml[8], S[8];
#pragma unroll
        for (int j = 0; j < 8; ++j) { oml[j] = 1.0f - sigm(lbp[kcol + j] - lbp[HGW + kcol + j]); S[j] = 0.f; }
#pragma unroll 4
        for (int step = 0; step < T; ++step) {
            const int t = dir ? T - 1 - step : step; const size_t m = (size_t)(rowbase + t);
            const v4u q8 = *(const v4u*)(HQ + m * HGW + kcol); const f16x8_t z8 = *(const f16x8_t*)(Z + m * HGW + kcol); const float v = bf1(HI[m * HGW + vcol]);
            const float q[8] = {bflo(q8.x), bfhi(q8.x), bflo(q8.y), bfhi(q8.y), bflo(q8.z), bfhi(q8.z), bflo(q8.w), bfhi(q8.w)};
            float o = 0.f;
#pragma unroll
            for (int j = 0; j < 8; ++j) { const float kk = oml[j] * __builtin_amdgcn_rcpf(1.0f + __expf((float)z8[j])); S[j] = (1.0f - kk) * S[j] + kk * v; o += S[j] * q[j]; }
            o += __shfl_xor(o, 1); o += __shfl_xor(o, 2); o += __shfl_xor(o, 4); o += __shfl_xor(o, 8);
            if (kg == 0) O[m * HGW + vcol] = o;
        }
    }
}
__device__ __forceinline__ void hgrn_combine(const float* OF, const float* OB, const float* hgw, const u16* HOG, u16* OHG, int gw, int NGW, int lane) {
    for (int it = gw; it < M * 16; it += NGW) {
        const size_t off = (size_t)(it >> 4) * HGW + (it & 15) * 128 + 2 * lane;
        const f32x2_t a = *(const f32x2_t*)(OF + off), b = *(const f32x2_t*)(OB + off); const float o0 = a.x + b.x, o1 = a.y + b.y;
        const float rstd = 1.0f / sqrtf(wave_sum(o0 * o0 + o1 * o1) * (1.0f / 128.0f) + EPS);
        const unsigned g = *(const unsigned*)(HOG + off); const f32x2_t w = *(const f32x2_t*)(hgw + (it & 15) * 128 + 2 * lane);
        *(unsigned*)(OHG + off) = pkbf(o0 * rstd * w.x * bflo(g), o1 * rstd * w.y * bfhi(g));
    }
}

#if defined(GEMM_RS)
#define GEMM_RUN(EPI) gemm_rs<EPI, pg8::StaticOrder>
#elif defined(GEMM_DRAIN)
#define GEMM_RUN(EPI) gemm_units<EPI>
#else
#ifndef GEMM_SP2
#define GEMM_SP2 true
#endif
#ifndef GEMM_ALIGN
#define GEMM_ALIGN true
#endif
#define GEMM_RUN(EPI) pg8::gemm_phase<EPI, pg8::StaticOrder, GEMM_ALIGN, GEMM_SP2>
#endif
constexpr int NPH = 11;
struct Args { const float* in[16]; float* out; unsigned char* ws; int ph_lo, ph_hi, dbg, pad; };
__global__ void __launch_bounds__(NWAVES * 64, 2) fwd_kernel(Args args) {
    extern __shared__ __attribute__((aligned(16))) unsigned char lds[];
    LAS unsigned char* ldsl = (LAS unsigned char*)lds;
    volatile LAS unsigned* MISC = (volatile LAS unsigned*)(ldsl + MISC_OFF);
    const int tid = threadIdx.x, lane = tid & 63, wave = __builtin_amdgcn_readfirstlane(tid >> 6);
    const int G = gridDim.x; const int bx = blockIdx.x; const int vcu = (G % 8 == 0) ? (bx % 8) * (G / 8) + bx / 8 : bx;
    const int gw = vcu * NWAVES + wave, NGW = G * NWAVES;
    unsigned char* ws = args.ws; unsigned char* dob = (unsigned char*)args.out;
    gu32* ctl = (gu32*)(ws + WS_CTL);
    for (int u = tid; u < (LDS_BYTES - 131072) / 4; u += NWAVES * 64) ((LAS unsigned*)(ldsl + 131072))[u] = 0u;
    __syncthreads();
    XcdBarrier bar = xcd_barrier_post((unsigned*)(ctl + CW_BAR), MISC + 8);
    const int lo = args.ph_lo, hi = args.ph_hi;
#ifdef DBG_FENCE
    __builtin_amdgcn_fence(__ATOMIC_ACQUIRE, "agent"); asm volatile("s_waitcnt vmcnt(0)" ::: "memory"); __syncthreads();
#endif
#ifndef PH_MASK
#define PH_MASK 0x1fff
#endif
#define IN(k) (((PH_MASK >> (k)) & 1) && lo <= (k) && (k) < hi)
#define SEAM(k) do { if (IN((k) + 1)) xcd_barrier(bar); } while (0)
#define WIN_t ((u16*)(dol + DO_WIN))
#define Hn ((u16*)(dol + DO_H))
#define WA_t ((u16*)(wsl + WS_WA))
#define WB_t ((u16*)(wsl + WS_WB))
#define WOUT_t ((u16*)(wsl + WS_WOUT))
#define WGU_t ((u16*)(wsl + WS_WGU))
#define WDN_t ((u16*)(wsl + WS_WDN))
#define PHASE_PTRS unsigned char* wsl = ws; unsigned char* dol = dob; int zph = 0; int tidl_ = threadIdx.x; asm volatile("" : "+s"(wsl), "+s"(dol), "+s"(zph), "+v"(tidl_)); const int tid = tidl_, lane = tidl_ & 63; (void)tid; (void)lane
#define INP(k) (args.in[(k) + zph])

    if (IN(0)) { PHASE_PTRS;
        LAS float* scr = (LAS float*)(ldsl + wave * 16384);
        constexpr int I_IN = (DM / 64) * (INW / 32), I_A = (HGW / 64) * (DM / 32), I_O = (DM / 64) * (DM / 32), I_GU = (DM / 64) * (2 * DFF / 32), I_DN = (DFF / 64) * (DM / 32);
        constexpr int NITEMS = I_IN + 2 * I_A + I_O + I_GU + I_DN;
        for (int it = gw; it < NITEMS; it += NGW) {
            int r = it;
            if (r < I_IN) { tr_item(INP(3), DM, INW, WIN_t, scr, r, lane, false); continue; } r -= I_IN;
            if (r < I_A) { tr_item(INP(9), HGW, DM, WA_t, scr, r, lane, false); continue; } r -= I_A;
            if (r < I_A) { tr_item(INP(10), AW, DM, WB_t, scr, r, lane, false); continue; } r -= I_A;
            if (r < I_O) { tr_item(INP(11), DM, DM, WOUT_t, scr, r, lane, false); continue; } r -= I_O;
            if (r < I_GU) { tr_item(INP(13), DM, 2 * DFF, WGU_t, scr, r, lane, true); continue; } r -= I_GU;
            tr_item(INP(14), DFF, DM, WDN_t, scr, r, lane, false);
        }
        for (int m = gw; m < M; m += NGW) rms_row(m < T0 ? INP(0) + (size_t)m * DM : INP(1) + (size_t)(m - T0) * DM, INP(2), Hn + (size_t)m * DM, nullptr, lane);
        SEAM(0);
    }
    if (IN(1)) { PHASE_PTRS;
        pg8::Gemm g{Hn, WIN_t, M, INW, DM}; pg8::StaticOrder S; S.init(M, INW, G, bx);
        EpiInProj E{wsl};
        GEMM_RUN(EpiInProj)(ldsl, g, S, E);
        SEAM(1);
    }
    if (IN(2)) { PHASE_PTRS;
        k_norm_rope((u16*)(wsl + WS_AK), INP(8), gw, NGW, lane);
        hgrn_scan_naive((const u16*)(wsl + WS_HQ), (const u16*)(wsl + WS_ZF), (const u16*)(wsl + WS_ZB), (const u16*)(wsl + WS_HI), INP(4), INP(5), (float*)(dol + DO_OF), (float*)(dol + DO_OB), vcu, G, tid);
        SEAM(2);
    }
    if (IN(3)) { PHASE_PTRS;
        u16* AQ = (u16*)(wsl + WS_AQ); const u16* AK = (const u16*)(wsl + WS_AK); const u16* AV = (const u16*)(wsl + WS_AV);
        for (int idx = vcu; idx < 1536; idx += G) {
            int seq, kvh, qh, qb;
            if (idx < 1024) { seq = 1; kvh = idx >> 8; const int rem = idx & 255; qh = kvh * 4 + (rem >> 6); qb = rem & 63; }
            else { const int j = idx - 1024; seq = 0; kvh = j >> 7; const int rem = j & 127; qh = kvh * 4 + (rem >> 5); qb = rem & 31; }
            const size_t rowbase = seq ? T0 : 0;
            att::attn_unit(AQ + (rowbase + (size_t)qb * 256) * AW + qh * 128, AK + rowbase * KVW + kvh * 128, AV + rowbase * KVW + kvh * 128, INP(7), qb * 256, seq ? T1 : T0, (char*)lds);
        }
        hgrn_combine((const float*)(dol + DO_OF), (const float*)(dol + DO_OB), INP(6), (const u16*)(wsl + WS_HOG), (u16*)(wsl + WS_HQ), gw, NGW, lane);
        SEAM(3);
    }
    if (IN(4)) { PHASE_PTRS;
        pg8::Gemm g{(const u16*)(wsl + WS_HQ), WA_t, M, DM, HGW}; pg8::StaticOrder S; S.init(M, DM, G, bx);
        EpiGate<false> E{(const u16*)(wsl + WS_GA), nullptr, (u16*)(wsl + WS_T)};
        GEMM_RUN(EpiGate<false>)(ldsl, g, S, E);
        SEAM(4);
    }
    if (IN(5)) { PHASE_PTRS;
        pg8::Gemm g{(const u16*)(wsl + WS_AQ), WB_t, M, DM, AW}; pg8::StaticOrder S; S.init(M, DM, G, bx);
        EpiGate<true> E{(const u16*)(wsl + WS_GB), (const u16*)(wsl + WS_T), (u16*)(wsl + WS_MERGED)};
        GEMM_RUN(EpiGate<true>)(ldsl, g, S, E);
        SEAM(5);
    }
    if (IN(6)) { PHASE_PTRS;
        pg8::Gemm g{(const u16*)(wsl + WS_MERGED), WOUT_t, M, DM, DM}; pg8::StaticOrder S; S.init(M, DM, G, bx);
        EpiResF32 E{INP(0), INP(1), args.out};
        GEMM_RUN(EpiResF32)(ldsl, g, S, E);
        SEAM(6);
    }
    if (IN(7)) { PHASE_PTRS;
        for (int m = gw; m < M; m += NGW) rms_row(args.out + (size_t)m * DM, INP(12), (u16*)(wsl + WS_XN2) + (size_t)m * DM, nullptr, lane);
        SEAM(7);
    }
    if (IN(8)) { PHASE_PTRS;
        pg8::Gemm g{(const u16*)(wsl + WS_XN2), WGU_t, M, 2 * DFF, DM}; pg8::StaticOrder S; S.init(M, 2 * DFF, G, bx);
        EpiSwiGLU E{(u16*)(wsl + WS_ACT)};
        GEMM_RUN(EpiSwiGLU)(ldsl, g, S, E);
        SEAM(8);
    }
    if (IN(9)) { PHASE_PTRS;
        pg8::Gemm g{(const u16*)(wsl + WS_ACT), WDN_t, M, DM, DFF}; pg8::StaticOrder S; S.init(M, DM, G, bx);
        EpiResF32 E{args.out, args.out + (size_t)T0 * DM, args.out};
        GEMM_RUN(EpiResF32)(ldsl, g, S, E);
        SEAM(9);
    }
    if (IN(10)) { PHASE_PTRS;
        for (int m = gw; m < M; m += NGW) rms_row(args.out + (size_t)m * DM, INP(15), nullptr, args.out + (size_t)m * DM, lane);
    }
#ifdef DBG_STOP
    if (IN(11)) { PHASE_PTRS;
        const size_t n_out = (size_t)M * DM; const u16* src; size_t n16; float* dst; const u16* src2 = nullptr; size_t n16b = 0;
        float* tmp = (float*)(wsl + ((DBG_STOP == 2) ? WS_GA : WS_HQ));
        if (DBG_STOP == 0) { src = (const u16*)dob; n16 = (size_t)360 * MiB / 2; dst = tmp; src2 = (const u16*)(wsl + WS_WA); n16b = (WS_HQ - WS_WA) / 2; }
#ifdef DBG_GAONLY
        else if (DBG_STOP == 1) { src = (const u16*)(wsl + DBG_GAONLY); n16 = (size_t)96 * MiB / 2; dst = args.out; }
#else
        else if (DBG_STOP == 1) { src = (const u16*)(wsl + WS_HQ); n16 = (WS_END - WS_HQ) / 2; dst = args.out; }
#endif
        else if (DBG_STOP == 2) { src = (const u16*)dob; n16 = (size_t)384 * MiB / 2; dst = tmp; src2 = (const u16*)(wsl + WS_AK); n16b = (size_t)24 * MiB / 2; }
        else if (DBG_STOP == 3) { src = (const u16*)(wsl + WS_HQ); n16 = (size_t)96 * MiB / 2; dst = args.out; src2 = (const u16*)(wsl + WS_AQ); n16b = (size_t)96 * MiB / 2; }
        else if (DBG_STOP == 4) { src = (const u16*)(wsl + WS_T); n16 = (size_t)192 * MiB / 2; dst = args.out; }
        else if (DBG_STOP == 5) { src = (const u16*)(wsl + WS_MERGED); n16 = (size_t)192 * MiB / 2; dst = args.out; }
        else if (DBG_STOP == 6) { src = (const u16*)(wsl + WS_GB); n16 = (size_t)192 * MiB / 2; dst = args.out; }
        else if (DBG_STOP == 7) { src = (const u16*)(wsl + WS_XN2); n16 = (size_t)192 * MiB / 2; dst = args.out; }
        else { src = (const u16*)(wsl + WS_ACT); n16 = (size_t)516 * MiB / 2; dst = args.out; }
        for (size_t i = (size_t)bx * 512 + tid; i < n_out; i += (size_t)G * 512) {
            float a = 0.f;
#ifdef DBG_HASH
            for (size_t j = i; j < n16; j += n_out) a += (float)(((unsigned)src[j] * 2654435761u) >> 16);
#else
            for (size_t j = i; j < n16; j += n_out) a += (float)src[j];
#endif
            for (size_t j = i; j < n16b; j += n_out) a += (float)src2[j];
            dst[i] = a * (1.0f / 65536.0f);
        }
    }
    if (IN(12)) { PHASE_PTRS;
        const size_t n_out = (size_t)M * DM; const float* tmp = (const float*)(wsl + ((DBG_STOP == 2) ? WS_GA : WS_HQ));
        for (size_t i = (size_t)bx * 512 + tid; i < n_out; i += (size_t)G * 512) args.out[i] = tmp[i];
    }
#endif
#ifdef DBG_SEQ
    if (lo <= 13 && 13 < hi) {
        const size_t n4 = (size_t)M * DM / 4, n4p = (size_t)T0 * DM / 4;
        for (size_t i = (size_t)bx * 512 + threadIdx.x; i < n4; i += (size_t)G * 512) ((f32x4*)args.out)[i] = i < n4p ? ((const f32x4*)args.in[0])[i] : ((const f32x4*)args.in[1])[i - n4p];
    }
#endif
#ifdef DBG_FENCE
    asm volatile("s_waitcnt vmcnt(0)" ::: "memory"); __builtin_amdgcn_fence(__ATOMIC_RELEASE, "agent"); asm volatile("s_waitcnt vmcnt(0)" ::: "memory");
#endif
#undef IN
#undef INP
#undef WIN_t
#undef Hn
#undef WA_t
#undef WB_t
#undef WOUT_t
#undef WGU_t
#undef WDN_t
#undef SEAM
}

#ifndef MK_N_LAUNCHES
#define MK_N_LAUNCHES 1
#endif
extern "C" void kernel_launch(void* const* d_in, const int* in_sizes, int n_in, void* d_out, int out_size, void* d_ws, size_t ws_size, hipStream_t stream) {
    static int grid = 0;
    if (grid == 0) {
        if (n_in != 16 || in_sizes[0] != T0 * DM || in_sizes[1] != T1 * DM || out_size != M * DM || ws_size < WS_END) {
            fprintf(stderr, "kernel_launch: shape mismatch (n_in %d, out %d, ws %zu); nothing launched\n", n_in, out_size, ws_size); grid = -1; return; }
        int dev = 0, cus = 0, per_cu = 0;
        if (hipGetDevice(&dev) != hipSuccess || hipDeviceGetAttribute(&cus, hipDeviceAttributeMultiprocessorCount, dev) != hipSuccess) { grid = -1; return; }
        if (hipFuncSetAttribute((const void*)fwd_kernel, hipFuncAttributeMaxDynamicSharedMemorySize, LDS_BYTES) != hipSuccess) { fprintf(stderr, "kernel_launch: hipFuncSetAttribute failed\n"); grid = -1; return; }
        if (hipOccupancyMaxActiveBlocksPerMultiprocessor(&per_cu, (const void*)fwd_kernel, NWAVES * 64, LDS_BYTES) != hipSuccess || per_cu < 1) { fprintf(stderr, "kernel_launch: occupancy query says %d\n", per_cu); grid = -1; (void)hipGetLastError(); return; }
        grid = cus;
    }
    if (grid < 0) return;
    if (hipMemsetAsync((char*)d_ws + WS_CTL, 0, CTL_ZERO_BYTES, stream) != hipSuccess) return;
    Args a{};
    for (int i = 0; i < 16; ++i) a.in[i] = (const float*)d_in[i];
    a.out = (float*)d_out; a.ws = (unsigned char*)d_ws;
#ifndef DBG_FLAGS
#define DBG_FLAGS 0
#endif
    a.dbg = DBG_FLAGS;
    if (MK_N_LAUNCHES == 1) { a.ph_lo = 0; a.ph_hi = NPH; hipLaunchKernelGGL(fwd_kernel, dim3(grid), dim3(NWAVES * 64), LDS_BYTES, stream, a); }
    else {
#ifdef DBG_SEQ
        { const int seq[] = {DBG_SEQ}; for (int p : seq) { a.ph_lo = p; a.ph_hi = p + 1; hipLaunchKernelGGL(fwd_kernel, dim3(grid), dim3(NWAVES * 64), LDS_BYTES, stream, a); } }
#elif defined(DBG_STOP)
        for (int p = 0; p <= DBG_STOP; ++p) { a.ph_lo = p; a.ph_hi = p + 1;
#ifdef DBG_DUMMY
            if (p == DBG_STOP) for (int d = 0; d < DBG_DUMMY; ++d) { Args b = a; b.ph_lo = 20; b.ph_hi = 21; hipLaunchKernelGGL(fwd_kernel, dim3(grid), dim3(NWAVES * 64), LDS_BYTES, stream, b); }
#endif
            if (p == 6 && (DBG_FLAGS & 16)) (void)hipMemcpyAsync((char*)d_ws + WS_HQ, (char*)d_ws + WS_MERGED, (size_t)192 * MiB, hipMemcpyDeviceToDevice, stream);
            hipLaunchKernelGGL(fwd_kernel, dim3(grid), dim3(NWAVES * 64), LDS_BYTES, stream, a); }
#ifdef DBG_P6GATE
        if (DBG_STOP != 9) {
#else
        if (DBG_STOP != 6 && DBG_STOP != 9) {
#endif
#ifdef DBG_DUMMY2
            for (int d = 0; d < DBG_DUMMY2; ++d) { Args b = a; b.ph_lo = 20; b.ph_hi = 21; hipLaunchKernelGGL(fwd_kernel, dim3(grid), dim3(NWAVES * 64), LDS_BYTES, stream, b); }
#endif
            a.ph_lo = 11; a.ph_hi = 12; hipLaunchKernelGGL(fwd_kernel, dim3(grid), dim3(NWAVES * 64), LDS_BYTES, stream, a);
            if (DBG_STOP == 0 || DBG_STOP == 2) { a.ph_lo = 12; a.ph_hi = 13; hipLaunchKernelGGL(fwd_kernel, dim3(grid), dim3(NWAVES * 64), LDS_BYTES, stream, a); } }
#else
        for (int p = 0; p < NPH; ++p) { a.ph_lo = p; a.ph_hi = p + 1; hipLaunchKernelGGL(fwd_kernel, dim3(grid), dim3(NWAVES * 64), LDS_BYTES, stream, a); }
#endif
    }
    const hipError_t le = hipPeekAtLastError();
    if (le != hipSuccess) fprintf(stderr, "kernel_launch: launch failed: %s\n", hipGetErrorName(le));
}
```

```cpp
#include <hip/hip_runtime.h>
#include <cstdio>
#include <cstdint>
namespace pg8 {
#define PG8_LAS __attribute__((address_space(3)))
typedef unsigned short bf16_t;
typedef short bf16x8 __attribute__((ext_vector_type(8)));
typedef float f32x4 __attribute__((ext_vector_type(4)));
typedef unsigned u32x4 __attribute__((ext_vector_type(4)));
constexpr int BM = 256, BK = 64, HALF = 128, HTB = HALF * BK * 2  , STAGE_BYTES = 8 * HTB, NXCD = 8, WGM = 4;

__host__ __device__ __forceinline__ int lds_byte(int r, int c) { const int st = (r >> 4) * 2 + (c >> 5), rr = r & 15, cc = c & 31, ob = rr * 64 + cc * 2; return st * 1024 + (ob ^ (((ob >> 9) & 1) << 5)); }
__host__ __device__ __forceinline__ void stage_rc(int b, int& R, int& C) { const int st = b / 1024, sb = b % 1024, swz = sb ^ (((sb >> 9) & 1) << 5); R = (st >> 1) * 16 + swz / 64; C = (st & 1) * 32 + (swz % 64) / 2; }
__host__ __device__ __forceinline__ int perm32(int rho) { const int n = rho >> 4, i = rho & 15; return 8 * (i >> 2) + 4 * n + (i & 3); }

struct Unit { int pm, pn; };
struct Gemm { const bf16_t* A; const bf16_t* Bt; int M, N, K; };

struct StaticOrder {
    int nM, nN, nwg, G, c, wgm;
    __host__ __device__ void init(int M, int N, int G_, int c_, int wgm_ = WGM) { nM = M / BM; nN = N / BM; nwg = nM * nN; G = G_; c = c_; wgm = wgm_; }
    __host__ __device__ bool next(int i, Unit& u) const {
        const long L = (long)i * G + c; if (L >= nwg) return false;
        int wgid = (int)L; { const int q = nwg / NXCD, r = nwg % NXCD, xcd = wgid % NXCD, off = wgid / NXCD; wgid = (xcd < r ? xcd * (q + 1) : r * (q + 1) + (xcd - r) * q) + off; }
        const int nig = wgm * nN, gid = wgid / nig, fm = gid * wgm, gsz = (nM - fm) < wgm ? (nM - fm) : wgm;
        u.pm = fm + ((wgid % nig) % gsz); u.pn = (wgid % nig) / gsz; if (gid & 1) u.pn = nN - 1 - u.pn;
        return true;
    }
    __device__ __forceinline__ void a_ready(const Unit&) const {}
    __device__ __forceinline__ void done(const Unit&) const {}
};
__device__ __forceinline__ unsigned cvt_pk_bf16(float lo, float hi) { unsigned r; asm volatile("v_cvt_pk_bf16_f32 %0, %1, %2" : "=v"(r) : "v"(lo), "v"(hi)); return r; }
typedef float f32x2 __attribute__((ext_vector_type(2)));
template <class Epi, class Sched, bool ALIGN_EPI = false, bool SP2 = false>
__device__ __forceinline__ void gemm_phase(PG8_LAS unsigned char* lds, const Gemm g, const Sched& S, const Epi& E) {
    const int tid = threadIdx.x, wid = __builtin_amdgcn_readfirstlane(tid >> 6), lane = tid & 63, wr = wid >> 2, wc = wid & 3, fr = lane & 15, fq = lane >> 4;
    const int K = g.K, nt = K / BK;
    unsigned voffA[2], voffB[2];
#pragma unroll
    for (int i = 0; i < 2; ++i) { int R, C; stage_rc(tid * 16 + i * 8192, R, C); const int Rb = Epi::PERM ? ((R & ~31) + perm32(R & 31)) : R;
        voffA[i] = (unsigned)(R * K + C) * 2u; voffB[i] = (unsigned)(Rb * K + C) * 2u; }
    const size_t kstep = (size_t)(BK * 2);
    const size_t hstep = (size_t)HALF * K * 2;
    const size_t tstep = 2 * hstep;
    const unsigned ldsw = (unsigned)wid * 1024u;
    const int aoff = lds_byte(wr * 64 + fr, fq * 8), boff = lds_byte(wc * 32 + fr, fq * 8);
#define PG8_SA(b, h) (((b) * 2 + (h)) * HTB)
#define PG8_SB(b, h) ((4 + (b) * 2 + (h)) * HTB)
#define PG8_STAGE(bufoff, gbase, voff) do { _Pragma("unroll") for (int _i = 0; _i < 2; ++_i) \
        __builtin_amdgcn_global_load_lds((const unsigned*)((const char*)(gbase) + (voff)[_i]), (PG8_LAS unsigned*)(lds + (bufoff) + ldsw + _i * 8192), 16, 0, 0); } while (0)
#define PG8_LDA(dst, b, h) do { _Pragma("unroll") for (int m = 0; m < 4; ++m) _Pragma("unroll") for (int k = 0; k < 2; ++k) dst[m][k] = *(const PG8_LAS bf16x8*)(lds + PG8_SA(b, h) + aoff + m * 2048 + k * 1024); } while (0)
#define PG8_LDB(dst, b, h) do { _Pragma("unroll") for (int n = 0; n < 2; ++n) _Pragma("unroll") for (int k = 0; k < 2; ++k) dst[n][k] = *(const PG8_LAS bf16x8*)(lds + PG8_SB(b, h) + boff + n * 2048 + k * 1024); } while (0)
#define PG8_MMA(ai, bj, At, Bt) do { __builtin_amdgcn_s_setprio(1); _Pragma("unroll") for (int m = 0; m < 4; ++m) _Pragma("unroll") for (int n = 0; n < 2; ++n) _Pragma("unroll") for (int k = 0; k < 2; ++k) \
        acc[ai][bj][m][n] = __builtin_amdgcn_mfma_f32_16x16x32_bf16(Bt[n][k], At[m][k], acc[ai][bj][m][n], 0, 0, 0); __builtin_amdgcn_s_setprio(0); } while (0)
#define PG8_WAIT_V(n) asm volatile("s_waitcnt vmcnt(" #n ")" ::: "memory")
#define PG8_WAIT_L(n) asm volatile("s_waitcnt lgkmcnt(" #n ")" ::: "memory")
#define PG8_BAR __builtin_amdgcn_s_barrier()
#define PG8_SCHED __builtin_amdgcn_sched_barrier(0)
    Unit cur, nxt; int ui = 0;
    if (!S.next(0, cur)) return;
    f32x4 acc[2][2][4][2];
#pragma unroll
    for (int a = 0; a < 2; ++a)
#pragma unroll
        for (int b = 0; b < 2; ++b)
#pragma unroll
            for (int m = 0; m < 4; ++m)
#pragma unroll
                for (int n = 0; n < 2; ++n) acc[a][b][m][n] = (f32x4){0.f, 0.f, 0.f, 0.f};
    bf16x8 At[4][2], B0[2][2], B1[2][2];
    const char* cA = (const char*)g.A + (size_t)cur.pm * tstep; const char* cB = (const char*)g.Bt + (size_t)cur.pn * tstep;
    S.a_ready(cur);
    if constexpr (SP2) {
        PG8_STAGE(PG8_SB(0, 0), cB, voffB); PG8_STAGE(PG8_SB(0, 1), cB + hstep, voffB); PG8_STAGE(PG8_SA(0, 0), cA, voffA); PG8_STAGE(PG8_SA(0, 1), cA + hstep, voffA);
        if (wr == 1) PG8_BAR;
        PG8_WAIT_V(2); PG8_BAR;
        PG8_STAGE(PG8_SB(1, 0), cB + kstep, voffB); PG8_STAGE(PG8_SA(1, 0), cA + kstep, voffA); PG8_STAGE(PG8_SB(1, 1), cB + hstep + kstep, voffB);
        PG8_WAIT_V(6); PG8_BAR;
    } else {
        PG8_STAGE(PG8_SB(0, 0), cB, voffB); PG8_STAGE(PG8_SA(0, 0), cA, voffA); PG8_STAGE(PG8_SB(0, 1), cB + hstep, voffB); PG8_STAGE(PG8_SA(0, 1), cA + hstep, voffA);
        if (wr == 1) PG8_BAR;
        PG8_WAIT_V(4); PG8_BAR;
        PG8_STAGE(PG8_SB(1, 0), cB + kstep, voffB); PG8_STAGE(PG8_SA(1, 0), cA + kstep, voffA); PG8_STAGE(PG8_SB(1, 1), cB + hstep + kstep, voffB);
        PG8_WAIT_V(6); PG8_BAR;
    }
    for (;;) {
        const bool has_next = S.next(ui + 1, nxt);
        const char* nA = has_next ? (const char*)g.A + (size_t)nxt.pm * tstep : cA; const char* nB = has_next ? (const char*)g.Bt + (size_t)nxt.pn * tstep : cB;
        for (int t = 0; t < nt; t += 2) {
            const bool last = (t == nt - 2);
            const char* a1 = cA + (size_t)(t + 1) * kstep;
            const char* a2 = last ? nA : cA + (size_t)(t + 2) * kstep; const char* b2 = last ? nB : cB + (size_t)(t + 2) * kstep;
            const char* a3 = a2 + kstep; const char* b3 = b2 + kstep;
            if (last && has_next) S.a_ready(nxt);
            if constexpr (SP2) {
            PG8_LDB(B0, 0, 0); PG8_LDB(B1, 0, 1); PG8_SCHED; PG8_LDA(At, 0, 0); PG8_STAGE(PG8_SA(1, 1), a1 + hstep, voffA);
            PG8_WAIT_V(8); PG8_WAIT_L(0); PG8_BAR; PG8_MMA(0, 0, At, B0); PG8_MMA(0, 1, At, B1); PG8_BAR; PG8_SCHED;
            PG8_LDA(At, 0, 1); PG8_STAGE(PG8_SB(0, 0), b2, voffB); PG8_STAGE(PG8_SB(0, 1), b2 + hstep, voffB); PG8_STAGE(PG8_SA(0, 0), a2, voffA);
            PG8_WAIT_V(8); PG8_WAIT_L(0); PG8_BAR; PG8_MMA(1, 0, At, B0); PG8_MMA(1, 1, At, B1); PG8_BAR; PG8_SCHED;
            PG8_LDB(B0, 1, 0); PG8_LDB(B1, 1, 1); PG8_SCHED; PG8_LDA(At, 1, 0); PG8_STAGE(PG8_SA(0, 1), a2 + hstep, voffA);
            PG8_WAIT_V(8); PG8_WAIT_L(0); PG8_BAR; PG8_MMA(0, 0, At, B0); PG8_MMA(0, 1, At, B1); PG8_BAR; PG8_SCHED;
            PG8_LDA(At, 1, 1); PG8_STAGE(PG8_SB(1, 0), b3, voffB); PG8_STAGE(PG8_SB(1, 1), b3 + hstep, voffB); PG8_STAGE(PG8_SA(1, 0), a3, voffA);
            PG8_WAIT_V(8); PG8_WAIT_L(0); PG8_BAR; PG8_MMA(1, 0, At, B0); PG8_MMA(1, 1, At, B1); PG8_BAR; PG8_SCHED;
            } else {
            PG8_LDB(B0, 0, 0); PG8_SCHED; PG8_LDA(At, 0, 0); PG8_STAGE(PG8_SA(1, 1), a1 + hstep, voffA);
            PG8_WAIT_L(8); PG8_BAR; PG8_WAIT_L(0); PG8_MMA(0, 0, At, B0); PG8_BAR; PG8_SCHED;
            PG8_LDB(B1, 0, 1); PG8_STAGE(PG8_SB(0, 0), b2, voffB);
            PG8_BAR; PG8_WAIT_L(0); PG8_MMA(0, 1, At, B1); PG8_BAR;
            PG8_LDA(At, 0, 1); PG8_STAGE(PG8_SA(0, 0), a2, voffA);
            PG8_BAR; PG8_WAIT_L(0); PG8_MMA(1, 0, At, B0); PG8_BAR; PG8_SCHED;
            PG8_STAGE(PG8_SB(0, 1), b2 + hstep, voffB);
            PG8_WAIT_V(6); PG8_BAR; PG8_MMA(1, 1, At, B1); PG8_BAR;
            PG8_LDB(B0, 1, 0); PG8_SCHED; PG8_LDA(At, 1, 0); PG8_STAGE(PG8_SA(0, 1), a2 + hstep, voffA);
            PG8_WAIT_L(8); PG8_BAR; PG8_WAIT_L(0); PG8_MMA(0, 0, At, B0); PG8_BAR; PG8_SCHED;
            PG8_LDB(B1, 1, 1); PG8_STAGE(PG8_SB(1, 0), b3, voffB);
            PG8_BAR; PG8_WAIT_L(0); PG8_MMA(0, 1, At, B1); PG8_BAR;
            PG8_LDA(At, 1, 1); PG8_STAGE(PG8_SA(1, 0), a3, voffA);
            PG8_BAR; PG8_WAIT_L(0); PG8_MMA(1, 0, At, B0); PG8_BAR; PG8_SCHED;
            PG8_STAGE(PG8_SB(1, 1), b3 + hstep, voffB);
            PG8_WAIT_V(6); PG8_BAR; PG8_MMA(1, 1, At, B1); PG8_BAR;
            }
        }
        if constexpr (ALIGN_EPI) { if (wr == 0) PG8_BAR; }
        if constexpr (!Epi::AFTER_DRAIN) { E(acc, cur, wr, wc, fr, fq); S.done(cur); }
        if (!has_next) break;
#pragma unroll
        for (int a = 0; a < 2; ++a)
#pragma unroll
            for (int b = 0; b < 2; ++b)
#pragma unroll
                for (int m = 0; m < 4; ++m)
#pragma unroll
                    for (int n = 0; n < 2; ++n) acc[a][b][m][n] = (f32x4){0.f, 0.f, 0.f, 0.f};
        cur = nxt; cA = nA; cB = nB; ++ui;
        if constexpr (ALIGN_EPI) { if (wr == 1) PG8_BAR; }
    }
    PG8_WAIT_V(0);
    if constexpr (!ALIGN_EPI) { if (wr == 0) PG8_BAR; }
    PG8_BAR;
    if constexpr (Epi::AFTER_DRAIN) { E.fused(acc, cur, wr, wc, fr, fq, lds, wid, lane); S.done(cur); }
#undef PG8_SA
#undef PG8_SB
#undef PG8_STAGE
#undef PG8_LDA
#undef PG8_LDB
#undef PG8_MMA
#undef PG8_WAIT_V
#undef PG8_WAIT_L
#undef PG8_BAR
#undef PG8_SCHED
}
}
#define GAS __attribute__((address_space(1)))
#define LAS __attribute__((address_space(3)))
typedef unsigned short bf16;
typedef unsigned v4u __attribute__((ext_vector_type(4)));
typedef float f32x4 __attribute__((ext_vector_type(4)));
typedef short bf16x8 __attribute__((ext_vector_type(8)));
typedef GAS unsigned gu32;
typedef GAS unsigned long long gu64;
#define RLX_AGENT __ATOMIC_RELAXED, __HIP_MEMORY_SCOPE_AGENT
#define LDS_WAIT() asm volatile("s_waitcnt lgkmcnt(0)" ::: "memory")
#define VM_WAIT() asm volatile("s_waitcnt vmcnt(0)" ::: "memory")
__device__ __forceinline__ unsigned long long rt() { return __builtin_amdgcn_s_memrealtime(); }
__device__ __forceinline__ unsigned f2bf(float f) { unsigned u = __builtin_bit_cast(unsigned, f); return (u + 0x7fffu + ((u >> 16) & 1u)) >> 16; }
__device__ __forceinline__ unsigned pk2(float lo, float hi) { return f2bf(lo) | (f2bf(hi) << 16); }
#define XB_TMO      128
#define XB_XCNT(j)  (256  + 64 * (j))
#define XB_XSUB(j)  (1280 + 64 * (j))
#define XB_XGEN(j)  (2304 + 64 * (j))
#define XB_TOP      3328
#define XB_TOPGEN   3392
#define XCD_BAR_WORDS 3456
#define XB_SPIN_CAP (1u << 22)

__device__ __forceinline__ unsigned xb_ld(unsigned* p)              { return __hip_atomic_load(p, __ATOMIC_RELAXED, __HIP_MEMORY_SCOPE_AGENT); }
__device__ __forceinline__ unsigned xb_add(unsigned* p, unsigned v) { return __hip_atomic_fetch_add(p, v, __ATOMIC_RELAXED, __HIP_MEMORY_SCOPE_AGENT); }
__device__ __forceinline__ unsigned xb_xcc_id() { return (unsigned)__builtin_amdgcn_s_getreg((3 << 11) | 20) & 0xFu; }
#define XB_SPIN(cond, bar) do { unsigned _sp = 0; while (cond) { __builtin_amdgcn_s_sleep(1); \
    if ((++_sp & 255u) == 0u) { if (xb_ld(&(bar)[XB_TMO])) break; if (_sp > XB_SPIN_CAP) { atomicAdd(&(bar)[XB_TMO], 1u); break; } } } } while (0)

struct XcdBarrier {
    unsigned* bar; unsigned x;
    volatile LAS unsigned* st;
};

__device__ __forceinline__ XcdBarrier xcd_barrier_post(unsigned* bar, volatile LAS unsigned* st) {
    XcdBarrier b; b.bar = bar; b.x = xb_xcc_id(); b.st = st;
    if (threadIdx.x == 0) (void)xb_add(&bar[XB_XCNT(b.x)], 1u);
    return b;
}
__device__ __forceinline__ void xcd_barrier_complete(unsigned* bar, unsigned x, unsigned& nloc, unsigned& nx) {
    const unsigned G = gridDim.x * gridDim.y * gridDim.z;
    unsigned sum, cnt, mine, sp = 0u;
    for (;;) {
        sum = 0u; cnt = 0u; mine = 0u;
#pragma unroll
        for (unsigned j = 0; j < 16; ++j) { const unsigned c = xb_ld(&bar[XB_XCNT(j)]); sum += c; cnt += (c > 0u) ? 1u : 0u; mine = (j == x) ? c : mine; }
        if (sum == G) break;
        __builtin_amdgcn_s_sleep(1);
        if ((++sp & 255u) == 0u) { if (xb_ld(&bar[XB_TMO])) break; if (sp > XB_SPIN_CAP) { atomicAdd(&bar[XB_TMO], 1u); break; } }
    }
    nloc = mine > 0u ? mine : 1u; nx = cnt > 0u ? cnt : 1u;
}

__device__ __forceinline__ void xcd_barrier(const XcdBarrier& b) {
    asm volatile("s_waitcnt vmcnt(0)" ::: "memory");
    __syncthreads();
    if (threadIdx.x == 0) {
        unsigned* bar = b.bar;
        __builtin_amdgcn_s_waitcnt(0);
        unsigned nloc = b.st[0], nx = b.st[1];
        if (nloc == 0u) { xcd_barrier_complete(bar, b.x, nloc, nx); b.st[0] = nloc; b.st[1] = nx; }
        const unsigned old = xb_add(&bar[XB_XSUB(b.x)], 1u);
        const unsigned gen = old / nloc;
        if (old + 1u == (gen + 1u) * nloc) {
            __builtin_amdgcn_fence(__ATOMIC_RELEASE, "agent");
            asm volatile("s_waitcnt vmcnt(0)" ::: "memory");
            const unsigned og = xb_add(&bar[XB_TOP], 1u);
            const unsigned tg = og / nx;
            if (og + 1u == (tg + 1u) * nx) xb_add(&bar[XB_TOPGEN], 1u);
            else XB_SPIN(xb_ld(&bar[XB_TOPGEN]) == tg, bar);
            __builtin_amdgcn_fence(__ATOMIC_ACQUIRE, "agent");
            xb_add(&bar[XB_XGEN(b.x)], 1u);
            asm volatile("s_waitcnt vmcnt(0)" ::: "memory");
        } else {
            XB_SPIN(xb_ld(&bar[XB_XGEN(b.x)]) == gen, bar);
            __builtin_amdgcn_fence(__ATOMIC_ACQUIRE, "agent");
            asm volatile("s_waitcnt vmcnt(0)" ::: "memory");
        }
    }
    __syncthreads();
}
__device__ __forceinline__ float wave_sum(float v) {
#pragma unroll
    for (int o = 1; o < 64; o <<= 1) v += __shfl_xor(v, o);
    return v;
}

typedef unsigned short u16;
typedef float f32x2_t __attribute__((ext_vector_type(2)));
constexpr int NWAVES = 8;
constexpr int DM = 4096, T0 = 8192, T1 = 16384, M = T0 + T1;
constexpr int HGW = 2048, AW = 2048, KVW = 512, INW = 21504, DFF = 11008;
constexpr float EPS = 1e-6f;
constexpr size_t MiB = 1u << 20;
constexpr size_t WS_CTL = 0, CTL_ZERO_BYTES = 65536;
constexpr size_t WS_WA = 1 * MiB, WS_WB = 17 * MiB, WS_WOUT = 33 * MiB, WS_WGU = 65 * MiB, WS_WDN = 237 * MiB;
constexpr size_t WS_HQ = 323 * MiB, WS_ZF = 419 * MiB, WS_ZB = 515 * MiB, WS_HI = 611 * MiB, WS_HOG = 707 * MiB, WS_AQ = 803 * MiB;
constexpr size_t WS_AK = 899 * MiB, WS_AV = 923 * MiB, WS_GA = 947 * MiB, WS_GB = 1139 * MiB, WS_END = 1331 * MiB;
constexpr size_t WS_T = WS_ZF, WS_MERGED = WS_HI, WS_XN2 = WS_GA, WS_ACT = WS_HQ, WS_X1B = WS_GB, WS_X2B = WS_GA;
constexpr size_t DO_WIN = 0, DO_H = 168 * MiB, DO_OF = 0, DO_OB = 192 * MiB;
static_assert(WS_ACT + (size_t)M * DFF * 2 <= WS_AK && DO_H + (size_t)M * DM * 2 <= (size_t)M * DM * 4, "maps");
constexpr int CW_BAR = 4096;
constexpr int LDS_BYTES = 147456;
constexpr int MISC_OFF = 131072 + 320;

typedef _Float16 f16x2_t __attribute__((ext_vector_type(2)));
typedef _Float16 f16x8_t __attribute__((ext_vector_type(8)));
typedef unsigned u32x2_t __attribute__((ext_vector_type(2)));
typedef __bf16 bf16x2_t __attribute__((ext_vector_type(2)));
__device__ __forceinline__ unsigned pkbf(float lo, float hi) { f32x2_t v = {lo, hi}; bf16x2_t b = __builtin_convertvector(v, bf16x2_t); return __builtin_bit_cast(unsigned, b); }
__device__ __forceinline__ unsigned pkh(float lo, float hi) { f32x2_t v = {lo, hi}; f16x2_t h = __builtin_convertvector(v, f16x2_t); return __builtin_bit_cast(unsigned, h); }
__device__ __forceinline__ float bflo(unsigned w) { return __uint_as_float(w << 16); }
__device__ __forceinline__ float bfhi(unsigned w) { return __uint_as_float(w & 0xffff0000u); }
__device__ __forceinline__ float bf1(u16 h) { return __uint_as_float(((unsigned)h) << 16); }
__device__ __forceinline__ float sigm(float x) { return __builtin_amdgcn_rcpf(1.0f + __expf(-x)); }

template <int OP>
__device__ __forceinline__ void epi_store16(const pg8::f32x4 (&acc)[2][2][4][2], u16* base, int ldc, int row0, int col0) {
#pragma unroll
    for (int ai = 0; ai < 2; ++ai)
#pragma unroll
        for (int m = 0; m < 4; ++m) { u16* rowp = base + (size_t)(row0 + ai * 128 + m * 16) * ldc + col0;
#pragma unroll
            for (int bj = 0; bj < 2; ++bj) { pg8::f32x4 v0 = acc[ai][bj][m][0], v1 = acc[ai][bj][m][1];
                if (OP == 2) {
#pragma unroll
                    for (int e = 0; e < 4; ++e) { v0[e] = v0[e] * sigm(v0[e]); v1[e] = v1[e] * sigm(v1[e]); } }
                if (OP == 3) {
#pragma unroll
                    for (int e = 0; e < 4; ++e) { v0[e] = sigm(v0[e]); v1[e] = sigm(v1[e]); } }
                pg8::u32x4 w;
                if (OP == 1) { w.x = pkh(v0[0], v0[1]); w.y = pkh(v0[2], v0[3]); w.z = pkh(v1[0], v1[1]); w.w = pkh(v1[2], v1[3]); }
                else { w.x = pkbf(v0[0], v0[1]); w.y = pkbf(v0[2], v0[3]); w.z = pkbf(v1[0], v1[1]); w.w = pkbf(v1[2], v1[3]); }
                *(pg8::u32x4*)(rowp + bj * 128) = w; } }
}
struct EpiInProj {
    static constexpr bool PERM = true, AFTER_DRAIN = false;
    unsigned char* ws;
    __device__ __forceinline__ void operator()(const pg8::f32x4 (&acc)[2][2][4][2], const pg8::Unit& u, int wr, int wc, int fr, int fq) const {
        const int pn = u.pn, row0 = u.pm * 256 + wr * 64 + fr, cw = wc * 32 + 8 * fq;
        if (pn < 8)       epi_store16<0>(acc, (u16*)(ws + WS_HQ), HGW, row0, (pn - 0) * 256 + cw);
        else if (pn < 16) epi_store16<1>(acc, (u16*)(ws + WS_ZF), HGW, row0, (pn - 8) * 256 + cw);
        else if (pn < 24) epi_store16<1>(acc, (u16*)(ws + WS_ZB), HGW, row0, (pn - 16) * 256 + cw);
        else if (pn < 32) epi_store16<0>(acc, (u16*)(ws + WS_HI), HGW, row0, (pn - 24) * 256 + cw);
        else if (pn < 40) epi_store16<2>(acc, (u16*)(ws + WS_HOG), HGW, row0, (pn - 32) * 256 + cw);
        else if (pn < 48) epi_store16<0>(acc, (u16*)(ws + WS_AQ), AW, row0, (pn - 40) * 256 + cw);
        else if (pn < 50) epi_store16<0>(acc, (u16*)(ws + WS_AK), KVW, row0, (pn - 48) * 256 + cw);
        else if (pn < 52) epi_store16<0>(acc, (u16*)(ws + WS_AV), KVW, row0, (pn - 50) * 256 + cw);
        else if (pn < 68) epi_store16<3>(acc, (u16*)(ws + WS_GA), DM, row0, (pn - 52) * 256 + cw);
        else              epi_store16<3>(acc, (u16*)(ws + WS_GB), DM, row0, (pn - 68) * 256 + cw);
    }
};
template <bool ADD> struct EpiGate {
    static constexpr bool PERM = true, AFTER_DRAIN = false;
    const u16* sg; const u16* tin; u16* out;
    __device__ __forceinline__ void operator()(const pg8::f32x4 (&acc)[2][2][4][2], const pg8::Unit& u, int wr, int wc, int fr, int fq) const {
        const int row0 = u.pm * 256 + wr * 64 + fr, col0 = u.pn * 256 + wc * 32 + 8 * fq;
#pragma unroll
        for (int ai = 0; ai < 2; ++ai)
#pragma unroll
            for (int mp = 0; mp < 2; ++mp) {
                pg8::u32x4 g[2][2], t[2][2];
#pragma unroll
                for (int mm = 0; mm < 2; ++mm)
#pragma unroll
                    for (int bj = 0; bj < 2; ++bj) { const size_t off = (size_t)(row0 + ai * 128 + (2 * mp + mm) * 16) * DM + col0 + bj * 128;
                        g[mm][bj] = *(const pg8::u32x4*)(sg + off); if (ADD) t[mm][bj] = *(const pg8::u32x4*)(tin + off); }
                __builtin_amdgcn_sched_barrier(0);
#pragma unroll
                for (int mm = 0; mm < 2; ++mm)
#pragma unroll
                    for (int bj = 0; bj < 2; ++bj) { const int m = 2 * mp + mm; const size_t off = (size_t)(row0 + ai * 128 + m * 16) * DM + col0 + bj * 128;
                        const pg8::f32x4 v0 = acc[ai][bj][m][0], v1 = acc[ai][bj][m][1]; const pg8::u32x4 gg = g[mm][bj];
                        float r[8] = {bflo(gg.x) * v0[0], bfhi(gg.x) * v0[1], bflo(gg.y) * v0[2], bfhi(gg.y) * v0[3], bflo(gg.z) * v1[0], bfhi(gg.z) * v1[1], bflo(gg.w) * v1[2], bfhi(gg.w) * v1[3]};
                        if (ADD) { const pg8::u32x4 tt = t[mm][bj];
                            r[0] += bflo(tt.x); r[1] += bfhi(tt.x); r[2] += bflo(tt.y); r[3] += bfhi(tt.y); r[4] += bflo(tt.z); r[5] += bfhi(tt.z); r[6] += bflo(tt.w); r[7] += bfhi(tt.w); }
                        pg8::u32x4 w; w.x = pkbf(r[0], r[1]); w.y = pkbf(r[2], r[3]); w.z = pkbf(r[4], r[5]); w.w = pkbf(r[6], r[7]);
                        *(pg8::u32x4*)(out + off) = w; }
                __builtin_amdgcn_sched_barrier(0);
            }
    }
};
struct EpiResF32 {
    static constexpr bool PERM = true, AFTER_DRAIN = false;
    const float* base0; const float* base1; float* out;
    __device__ __forceinline__ void operator()(const pg8::f32x4 (&acc)[2][2][4][2], const pg8::Unit& u, int wr, int wc, int fr, int fq) const {
        const int col0 = u.pn * 256 + wc * 32 + 8 * fq;
        const int r0t = u.pm * 256;
        const float* bt = (r0t < T0) ? base0 + (size_t)r0t * DM : base1 + (size_t)(r0t - T0) * DM; float* ot = out + (size_t)r0t * DM;
#pragma unroll
        for (int ai = 0; ai < 2; ++ai)
#pragma unroll
            for (int mp = 0; mp < 2; ++mp) {
                pg8::f32x4 b[2][2][2];
#pragma unroll
                for (int mm = 0; mm < 2; ++mm)
#pragma unroll
                    for (int bj = 0; bj < 2; ++bj) { const float* bs = bt + (size_t)(ai * 128 + wr * 64 + (2 * mp + mm) * 16 + fr) * DM + col0 + bj * 128;
                        b[mm][bj][0] = *(const pg8::f32x4*)bs; b[mm][bj][1] = *(const pg8::f32x4*)(bs + 4); }
                __builtin_amdgcn_sched_barrier(0);
#pragma unroll
                for (int mm = 0; mm < 2; ++mm)
#pragma unroll
                    for (int bj = 0; bj < 2; ++bj) { const int m = 2 * mp + mm; float* op = ot + (size_t)(ai * 128 + wr * 64 + m * 16 + fr) * DM + col0 + bj * 128;
                        *(pg8::f32x4*)op = b[mm][bj][0] + acc[ai][bj][m][0]; *(pg8::f32x4*)(op + 4) = b[mm][bj][1] + acc[ai][bj][m][1]; }
                __builtin_amdgcn_sched_barrier(0);
            }
    }
};
struct EpiResToB16 {
    static constexpr bool PERM = true, AFTER_DRAIN = false;
    const float* base0; const float* base1; u16* out;
    __device__ __forceinline__ void operator()(const pg8::f32x4 (&acc)[2][2][4][2], const pg8::Unit& u, int wr, int wc, int fr, int fq) const {
        const int col0 = u.pn * 256 + wc * 32 + 8 * fq;
        const int r0t = u.pm * 256;
        const float* bt = (r0t < T0) ? base0 + (size_t)r0t * DM : base1 + (size_t)(r0t - T0) * DM; u16* ot = out + (size_t)r0t * DM;
#pragma unroll
        for (int ai = 0; ai < 2; ++ai)
#pragma unroll
            for (int mp = 0; mp < 2; ++mp) {
                pg8::f32x4 b[2][2][2];
#pragma unroll
                for (int mm = 0; mm < 2; ++mm)
#pragma unroll
                    for (int bj = 0; bj < 2; ++bj) { const float* bs = bt + (size_t)(ai * 128 + wr * 64 + (2 * mp + mm) * 16 + fr) * DM + col0 + bj * 128;
                        b[mm][bj][0] = *(const pg8::f32x4*)bs; b[mm][bj][1] = *(const pg8::f32x4*)(bs + 4); }
                __builtin_amdgcn_sched_barrier(0);
#pragma unroll
                for (int mm = 0; mm < 2; ++mm)
#pragma unroll
                    for (int bj = 0; bj < 2; ++bj) { const int m = 2 * mp + mm; u16* op = ot + (size_t)(ai * 128 + wr * 64 + m * 16 + fr) * DM + col0 + bj * 128;
                        const pg8::f32x4 v0 = b[mm][bj][0] + acc[ai][bj][m][0], v1 = b[mm][bj][1] + acc[ai][bj][m][1];
                        pg8::u32x4 w; w.x = pkbf(v0[0], v0[1]); w.y = pkbf(v0[2], v0[3]); w.z = pkbf(v1[0], v1[1]); w.w = pkbf(v1[2], v1[3]);
                        *(pg8::u32x4*)op = w; }
                __builtin_amdgcn_sched_barrier(0);
            }
    }
};
struct EpiResFromB16 {
    static constexpr bool PERM = true, AFTER_DRAIN = false;
    const u16* res; float* out;
    __device__ __forceinline__ void operator()(const pg8::f32x4 (&acc)[2][2][4][2], const pg8::Unit& u, int wr, int wc, int fr, int fq) const {
        const size_t o0 = (size_t)(u.pm * 256 + wr * 64 + fr) * DM + u.pn * 256 + wc * 32 + 8 * fq;
#pragma unroll
        for (int ai = 0; ai < 2; ++ai) {
            pg8::u32x4 b[4][2];
#pragma unroll
            for (int m = 0; m < 4; ++m)
#pragma unroll
                for (int bj = 0; bj < 2; ++bj) b[m][bj] = *(const pg8::u32x4*)(res + o0 + (size_t)(ai * 128 + m * 16) * DM + bj * 128);
            __builtin_amdgcn_sched_barrier(0);
#pragma unroll
            for (int m = 0; m < 4; ++m)
#pragma unroll
                for (int bj = 0; bj < 2; ++bj) { float* op = out + o0 + (size_t)(ai * 128 + m * 16) * DM + bj * 128; const pg8::u32x4 g = b[m][bj];
                    const pg8::f32x4 r0 = {bflo(g.x), bfhi(g.x), bflo(g.y), bfhi(g.y)}, r1 = {bflo(g.z), bfhi(g.z), bflo(g.w), bfhi(g.w)};
                    *(pg8::f32x4*)op = r0 + acc[ai][bj][m][0]; *(pg8::f32x4*)(op + 4) = r1 + acc[ai][bj][m][1]; }
            __builtin_amdgcn_sched_barrier(0);
        }
    }
};
struct EpiPlainB16 {
    static constexpr bool PERM = true, AFTER_DRAIN = false;
    u16* out;
    __device__ __forceinline__ void operator()(const pg8::f32x4 (&acc)[2][2][4][2], const pg8::Unit& u, int wr, int wc, int fr, int fq) const {
        epi_store16<0>(acc, out, DM, u.pm * 256 + wr * 64 + fr, u.pn * 256 + wc * 32 + 8 * fq);
    }
};
struct EpiResB16 {
    static constexpr bool PERM = true, AFTER_DRAIN = false;
    const u16* res; u16* out;
    __device__ __forceinline__ void operator()(const pg8::f32x4 (&acc)[2][2][4][2], const pg8::Unit& u, int wr, int wc, int fr, int fq) const {
        const size_t o0 = (size_t)(u.pm * 256 + wr * 64 + fr) * DM + u.pn * 256 + wc * 32 + 8 * fq;
#pragma unroll
        for (int ai = 0; ai < 2; ++ai) {
            pg8::u32x4 b[4][2];
#pragma unroll
            for (int m = 0; m < 4; ++m)
#pragma unroll
                for (int bj = 0; bj < 2; ++bj) b[m][bj] = *(const pg8::u32x4*)(res + o0 + (size_t)(ai * 128 + m * 16) * DM + bj * 128);
            __builtin_amdgcn_sched_barrier(0);
#pragma unroll
            for (int m = 0; m < 4; ++m)
#pragma unroll
                for (int bj = 0; bj < 2; ++bj) { const pg8::u32x4 g = b[m][bj]; const pg8::f32x4 v0 = acc[ai][bj][m][0], v1 = acc[ai][bj][m][1];
                    pg8::u32x4 w; w.x = pkbf(bflo(g.x) + v0[0], bfhi(g.x) + v0[1]); w.y = pkbf(bflo(g.y) + v0[2], bfhi(g.y) + v0[3]); w.z = pkbf(bflo(g.z) + v1[0], bfhi(g.z) + v1[1]); w.w = pkbf(bflo(g.w) + v1[2], bfhi(g.w) + v1[3]);
                    *(pg8::u32x4*)(out + o0 + (size_t)(ai * 128 + m * 16) * DM + bj * 128) = w; }
            __builtin_amdgcn_sched_barrier(0);
        }
    }
};
struct EpiSwiGLU {
    static constexpr bool PERM = true, AFTER_DRAIN = false;
    u16* out;
    __device__ __forceinline__ void operator()(const pg8::f32x4 (&acc)[2][2][4][2], const pg8::Unit& u, int wr, int wc, int fr, int fq) const {
        const int row0 = u.pm * 256 + wr * 64 + fr, col0 = u.pn * 128 + wc * 32 + 8 * fq;
#pragma unroll
        for (int ai = 0; ai < 2; ++ai)
#pragma unroll
            for (int m = 0; m < 4; ++m) { const pg8::f32x4 g0 = acc[ai][0][m][0], g1 = acc[ai][0][m][1], u0 = acc[ai][1][m][0], u1 = acc[ai][1][m][1];
                float r[8];
#pragma unroll
                for (int e = 0; e < 4; ++e) { r[e] = g0[e] * sigm(g0[e]) * u0[e]; r[4 + e] = g1[e] * sigm(g1[e]) * u1[e]; }
                pg8::u32x4 w; w.x = pkbf(r[0], r[1]); w.y = pkbf(r[2], r[3]); w.z = pkbf(r[4], r[5]); w.w = pkbf(r[6], r[7]);
                *(pg8::u32x4*)(out + (size_t)(row0 + ai * 128 + m * 16) * DFF + col0) = w; }
    }
};


namespace att {
using bf16x8 = __attribute__((ext_vector_type(8))) short;
using s16x4  = __attribute__((ext_vector_type(4))) short;
using f32x16 = __attribute__((ext_vector_type(16))) float;
using u32x4  = __attribute__((ext_vector_type(4))) unsigned;
using f32x4  = __attribute__((ext_vector_type(4))) float;
constexpr int   D = 128, NW = 8, QBLK = 32, KVBLK = 64, LDQ = 2048, LDK = 512;
constexpr float SCALE = 0.088388347648318440f;
constexpr size_t SHM_V = KVBLK * D * 2, SHM_K = KVBLK * D * 2, RING = 4, WS_OFF = 132096;
#define KSWZ(row, colB) ((row) * 256 + ((colB) ^ (((row) & 15) << 4)))
#define SBAR() __builtin_amdgcn_sched_barrier(0)
__device__ __forceinline__ int crow(int r, int hi) { return (r & 3) + 8 * (r >> 2) + 4 * hi; }
__device__ __forceinline__ unsigned cvtpk(float lo, float hi) { return pkbf(lo, hi); }
template <bool SHIFT> __device__ __forceinline__ void partialSM(f32x16& p0, f32x16& p1, float negBl2) {
  constexpr float C = SCALE * 1.4426950408889634f;
  if constexpr (SHIFT) {
    for (int r = 0; r < 16; ++r) { float t = fmaf(p0[r], C, negBl2); asm("" : "+v"(t)); p0[r] = t; } for (int r = 0; r < 16; ++r) { float t = fmaf(p1[r], C, negBl2); asm("" : "+v"(t)); p1[r] = t; } }
  for (int r = 0; r < 16; ++r) p0[r] = __builtin_amdgcn_exp2f(p0[r]);
}
__device__ __forceinline__ void qkt(f32x16& p0, f32x16& p1, const u16* Ks, const bf16x8* qr, int r32, int hi) {
  p0 = f32x16{}; p1 = f32x16{};
  const char* k0p = (const char*)Ks + r32 * 256; const char* k1p = k0p + 32 * 256; const int sw = (r32 & 15) << 4, hb = hi * 16;
#define QK_RD(d0, A, B) do { const int cb_ = ((d0) * 32 + hb) ^ sw; A = *reinterpret_cast<const bf16x8*>(k0p + cb_); B = *reinterpret_cast<const bf16x8*>(k1p + cb_); } while (0)
  bf16x8 a0, b0, a1, b1, c0, d0_, c1, d1;
  QK_RD(0, a0, b0); QK_RD(1, a1, b1);
#pragma unroll
  for (int g = 0; g < 4; ++g) {
    if (g < 3) { QK_RD(2 * g + 2, c0, d0_); QK_RD(2 * g + 3, c1, d1); }
    SBAR();
    p0 = __builtin_amdgcn_mfma_f32_32x32x16_bf16(a0, qr[2 * g], p0, 0, 0, 0); p1 = __builtin_amdgcn_mfma_f32_32x32x16_bf16(b0, qr[2 * g], p1, 0, 0, 0);
    p0 = __builtin_amdgcn_mfma_f32_32x32x16_bf16(a1, qr[2 * g + 1], p0, 0, 0, 0); p1 = __builtin_amdgcn_mfma_f32_32x32x16_bf16(b1, qr[2 * g + 1], p1, 0, 0, 0);
    SBAR();
    a0 = c0; b0 = d0_; a1 = c1; b1 = d1;
  }
#undef QK_RD
}
__device__ __forceinline__ int v_st(int k, int c) { const int kk = (k & ~0xC) | ((k & 4) << 1) | ((k & 8) >> 1); return ((kk >> 3) * 4 + (c >> 5)) * 512 + ((kk & 7) * 32 + (c & 31)) * 2; }
__device__ __forceinline__ int v_rd_base(int lane) { return ((lane & 3) << 3) | (((lane >> 2) & 3) << 6) | (((lane >> 4) & 1) << 5) | (((lane >> 5) & 1) << 8); }
constexpr int v_rd_off(int d0, int ks, int half) { return d0 * 512 + ks * 4096 + half * 2048; }
template <int OFF> __device__ __forceinline__ s16x4 tr_read(int vb) {
  s16x4 r; asm volatile("ds_read_b64_tr_b16 %0, %1 offset:%2" : "=&v"(r) : "v"(vb), "i"(OFF) : "memory"); return r;
}
template <int D0> __device__ __forceinline__ void pv_one(f32x16& od, int vb, bf16x8 pa0, bf16x8 pa1, bf16x8 pa2, bf16x8 pa3) {
  const s16x4 l0 = tr_read<v_rd_off(D0, 0, 0)>(vb), h0 = tr_read<v_rd_off(D0, 0, 1)>(vb), l1 = tr_read<v_rd_off(D0, 1, 0)>(vb), h1 = tr_read<v_rd_off(D0, 1, 1)>(vb);
  const s16x4 l2 = tr_read<v_rd_off(D0, 2, 0)>(vb), h2 = tr_read<v_rd_off(D0, 2, 1)>(vb), l3 = tr_read<v_rd_off(D0, 3, 0)>(vb), h3 = tr_read<v_rd_off(D0, 3, 1)>(vb);
  asm volatile("s_waitcnt lgkmcnt(0)" ::: "memory"); SBAR();
#define PK(L, H) (bf16x8){L[0], L[1], L[2], L[3], H[0], H[1], H[2], H[3]}
  od = __builtin_amdgcn_mfma_f32_32x32x16_bf16(pa0, PK(l0, h0), od, 0, 0, 0);
  od = __builtin_amdgcn_mfma_f32_32x32x16_bf16(pa1, PK(l1, h1), od, 0, 0, 0);
  od = __builtin_amdgcn_mfma_f32_32x32x16_bf16(pa2, PK(l2, h2), od, 0, 0, 0);
  od = __builtin_amdgcn_mfma_f32_32x32x16_bf16(pa3, PK(l3, h3), od, 0, 0, 0);
#undef PK
}
__device__ __forceinline__ void pv_d0(f32x16* o, int vb, bf16x8 pa0, bf16x8 pa1, bf16x8 pa2, bf16x8 pa3) {
  pv_one<0>(o[0], vb, pa0, pa1, pa2, pa3); pv_one<1>(o[1], vb, pa0, pa1, pa2, pa3); pv_one<2>(o[2], vb, pa0, pa1, pa2, pa3); pv_one<3>(o[3], vb, pa0, pa1, pa2, pa3);
}
#define PIN(x) asm volatile("" : "+v"(x))
#define MF32(a, b, c) __builtin_amdgcn_mfma_f32_32x32x16_bf16(a, b, c, 0, 0, 0)
struct VFrag { s16x4 l0, h0, l1, h1, l2, h2, l3, h3; };
#define VF_RD2(F, D0, KS, vb) do { F.l##KS = tr_read<v_rd_off(D0, KS, 0)>(vb); F.h##KS = tr_read<v_rd_off(D0, KS, 1)>(vb); } while (0)
#define VF_PK(F, KS) (bf16x8){F.l##KS[0], F.l##KS[1], F.l##KS[2], F.l##KS[3], F.h##KS[0], F.h##KS[1], F.h##KS[2], F.h##KS[3]}
#define PK4F(P, BASE, OUT) do { u32x4 w_ = {cvtpk(P[BASE + 0], P[BASE + 1]), cvtpk(P[BASE + 2], P[BASE + 3]), cvtpk(P[BASE + 4], P[BASE + 5]), cvtpk(P[BASE + 6], P[BASE + 7])}; \
    OUT = *reinterpret_cast<bf16x8*>(&w_); } while (0)
#define VF_RDF(F, D0, KS, vb) do { F.l##D0 = tr_read<v_rd_off(D0, KS, 0)>(vb); F.h##D0 = tr_read<v_rd_off(D0, KS, 1)>(vb); } while (0)
#define VF_PKF(F, D0) (bf16x8){F.l##D0[0], F.l##D0[1], F.l##D0[2], F.l##D0[3], F.h##D0[0], F.h##D0[1], F.h##D0[2], F.h##D0[3]}
#define BC8(w) __builtin_bit_cast(bf16x8, w)
template <int OFF> __device__ __forceinline__ bf16x8 kread(int a) { bf16x8 r; asm volatile("ds_read_b128 %0, %1 offset:%2" : "=&v"(r) : "v"(a), "i"(OFF) : "memory"); return r; }
__device__ __forceinline__ void stepA(f32x16& n0, f32x16& n1, const u16* Ks, const bf16x8* qr, int r32, int hi, f32x16& p0, f32x16& p1, float& lA,
                                      u32x4& w0, u32x4& w1, u32x4& w2, VFrag& vf, int vb) {
  const int swb = ((r32 & 15) << 4) ^ (hi * 16), kl = (int)(uintptr_t)Ks + r32 * 256;
  int kbm[8];
#pragma unroll
  for (int d = 0; d < 8; ++d) kbm[d] = kl + (swb ^ (d * 32));
#define KR(X, d0, B) X = kread<(B) * 8192>(kbm[d0])
#define GA(i, WN, MF, RD, CV) do { asm volatile("s_waitcnt lgkmcnt(" #WN ")" ::: "memory"); SBAR(); MF; RD; { float e_ = __builtin_amdgcn_exp2f(p1[i]); PIN(e_); p1[i] = e_; } \
    lA += ((i) == 0 ? p0[15] : p1[(i) == 0 ? 0 : (i) - 1]); CV; PIN(lA); SBAR(); } while (0)
  bf16x8 x0, x1, x2, x3, y0, y1, y2, y3;
  KR(x0, 0, 0); KR(x1, 0, 1); KR(x2, 1, 0); KR(x3, 1, 1); SBAR();
  GA(0,  3, n0 = MF32(x0, qr[0], f32x16{}), KR(y0, 2, 0), { w0[0] = cvtpk(p0[0], p0[1]);   PIN(w0); });
  GA(1,  3, n1 = MF32(x1, qr[0], f32x16{}), KR(y1, 2, 1), { w0[1] = cvtpk(p0[2], p0[3]);   PIN(w0); });
  GA(2,  3, n0 = MF32(x2, qr[1], n0),       KR(y2, 3, 0), { w0[2] = cvtpk(p0[4], p0[5]);   PIN(w0); });
  GA(3,  3, n1 = MF32(x3, qr[1], n1),       KR(y3, 3, 1), { w0[3] = cvtpk(p0[6], p0[7]);   PIN(w0); });
  GA(4,  3, n0 = MF32(y0, qr[2], n0),       KR(x0, 4, 0), { w1[0] = cvtpk(p0[8], p0[9]);   PIN(w1); });
  GA(5,  3, n1 = MF32(y1, qr[2], n1),       KR(x1, 4, 1), { w1[1] = cvtpk(p0[10], p0[11]); PIN(w1); });
  GA(6,  3, n0 = MF32(y2, qr[3], n0),       KR(x2, 5, 0), { w1[2] = cvtpk(p0[12], p0[13]); PIN(w1); });
  GA(7,  3, n1 = MF32(y3, qr[3], n1),       KR(x3, 5, 1), { w1[3] = cvtpk(p0[14], p0[15]); PIN(w1); });
  GA(8,  3, n0 = MF32(x0, qr[4], n0),       KR(y0, 6, 0), { w2[0] = cvtpk(p1[0], p1[1]);   PIN(w2); });
  GA(9,  3, n1 = MF32(x1, qr[4], n1),       KR(y1, 6, 1), { w2[1] = cvtpk(p1[2], p1[3]);   PIN(w2); });
  GA(10, 3, n0 = MF32(x2, qr[5], n0),       KR(y2, 7, 0), { w2[2] = cvtpk(p1[4], p1[5]);   PIN(w2); });
  GA(11, 3, n1 = MF32(x3, qr[5], n1),       KR(y3, 7, 1), { w2[3] = cvtpk(p1[6], p1[7]);   PIN(w2); });
  GA(12, 3, n0 = MF32(y0, qr[6], n0),       VF_RDF(vf, 0, 0, vb), {});
  GA(13, 4, n1 = MF32(y1, qr[6], n1),       VF_RDF(vf, 1, 0, vb), {});
  GA(14, 5, n0 = MF32(y2, qr[7], n0),       VF_RDF(vf, 2, 0, vb), {});
  GA(15, 6, n1 = MF32(y3, qr[7], n1),       VF_RDF(vf, 3, 0, vb), {});
#undef KR
#undef GA
}
struct DmaCtx { const u16* Kh; const u16* Vh; int kgo0, kgo1, vgo0, vgo1; LAS unsigned char* ldsa; int wid, s, NT; };
#define DMAP(base, t, go, ring_off, img, i) __builtin_amdgcn_global_load_lds((const unsigned*)((base) + (size_t)(t) * (KVBLK * LDK) + (go)), \
    (LAS unsigned*)(dc.ldsa + (ring_off) + ((t) & 3) * (img) + dc.wid * 1024 + (i) * 8192), 16, 0, 0)
template <bool SHIFT, bool DMA> __device__ __forceinline__ void stepB(f32x16* o, int vb, u32x4 w0, u32x4 w1, u32x4 w2, f32x16& p1, VFrag& vf, f32x16& n0, f32x16& n1, float& lA, float& lB, float negBl2, const DmaCtx& dc) {
  const int tk3 = (dc.s + 3 < dc.NT) ? dc.s + 3 : dc.NT - 1;
  constexpr float C = SCALE * 1.4426950408889634f;
  VFrag vg; u32x4 w3;
#define FB(j) do { if constexpr (SHIFT) { float t0_ = fmaf(n0[j], C, negBl2), t1_ = fmaf(n1[j], C, negBl2); PIN(t0_); PIN(t1_); n0[j] = t0_; n1[j] = t1_; \
      if ((j) > 0) { float e_ = __builtin_amdgcn_exp2f(n0[(j) > 0 ? (j) - 1 : 0]); PIN(e_); n0[(j) > 0 ? (j) - 1 : 0] = e_; } if ((j) > 1) lB += n0[(j) > 1 ? (j) - 2 : 0]; } \
    else { float e_ = __builtin_amdgcn_exp2f(n0[j]); PIN(e_); n0[j] = e_; if ((j) > 0) lB += n0[(j) > 0 ? (j) - 1 : 0]; } PIN(lB); } while (0)
#define GB(j, WN, W, F, D0, RD, EXTRA) do { asm volatile("s_waitcnt lgkmcnt(" #WN ")" ::: "memory"); SBAR(); o[D0] = MF32(BC8(W), VF_PKF(F, D0), o[D0]); RD; FB(j); EXTRA; SBAR(); } while (0)
  GB(0,  6,w0, vf, 0, VF_RDF(vg, 0, 1, vb), { w3[0] = cvtpk(p1[8], p1[9]);   lA += p1[15]; PIN(w3); PIN(lA); });
  GB(1,  6,w0, vf, 1, VF_RDF(vg, 1, 1, vb), { w3[1] = cvtpk(p1[10], p1[11]); PIN(w3); });
  GB(2,  6,w0, vf, 2, VF_RDF(vg, 2, 1, vb), { w3[2] = cvtpk(p1[12], p1[13]); PIN(w3); });
  GB(3,  6,w0, vf, 3, VF_RDF(vg, 3, 1, vb), { w3[3] = cvtpk(p1[14], p1[15]); PIN(w3); });
  GB(4,  6,w1, vg, 0, VF_RDF(vf, 0, 2, vb), {});
  GB(5,  6,w1, vg, 1, VF_RDF(vf, 1, 2, vb), {});
  GB(6,  6,w1, vg, 2, VF_RDF(vf, 2, 2, vb), {});
  GB(7,  6,w1, vg, 3, VF_RDF(vf, 3, 2, vb), {});
  GB(8,  6,w2, vf, 0, VF_RDF(vg, 0, 3, vb), { if constexpr (DMA) DMAP(dc.Kh, dc.s + 2, dc.kgo0, RING * SHM_V, SHM_K, 0); });
  GB(9,  6,w2, vf, 1, VF_RDF(vg, 1, 3, vb), { if constexpr (DMA) DMAP(dc.Kh, dc.s + 2, dc.kgo1, RING * SHM_V, SHM_K, 1); });
  GB(10, 6,w2, vf, 2, VF_RDF(vg, 2, 3, vb), { if constexpr (DMA) DMAP(dc.Vh, dc.s + 1, dc.vgo0, 0, SHM_V, 0); });
  GB(11, 6,w2, vf, 3, VF_RDF(vg, 3, 3, vb), { if constexpr (DMA) DMAP(dc.Vh, dc.s + 1, dc.vgo1, 0, SHM_V, 1); });
  GB(12, 6,w3, vg, 0, {}, { if constexpr (DMA) DMAP(dc.Kh, tk3, dc.kgo0, RING * SHM_V, SHM_K, 0); });
  GB(13, 4,w3, vg, 1, {}, { if constexpr (DMA) DMAP(dc.Kh, tk3, dc.kgo1, RING * SHM_V, SHM_K, 1); });
  GB(14, 2,w3, vg, 2, {}, { if constexpr (DMA) DMAP(dc.Vh, dc.s + 2, dc.vgo0, 0, SHM_V, 0); });
  GB(15, 0,w3, vg, 3, {}, { if constexpr (DMA) DMAP(dc.Vh, dc.s + 2, dc.vgo1, 0, SHM_V, 1); });
  if constexpr (SHIFT) { float e_ = __builtin_amdgcn_exp2f(n0[15]); PIN(e_); n0[15] = e_; lB += n0[14]; }
#undef FB
#undef GB
}
#undef DMAP
__device__ __forceinline__ void finish_last(f32x16& p0, f32x16& p1, float& l, bf16x8& pa0, bf16x8& pa1, bf16x8& pa2, bf16x8& pa3) {
  for (int r = 0; r < 16; ++r) p1[r] = __builtin_amdgcn_exp2f(p1[r]);
  float ps = p0[15]; for (int r = 0; r < 16; ++r) ps += p1[r];
  l += ps;
  PK4F(p0, 0, pa0); PK4F(p0, 8, pa1); PK4F(p1, 0, pa2); PK4F(p1, 8, pa3);
}
template <bool SHIFT> __device__ __forceinline__ void attn_unit(u16* Qb, const u16* __restrict__ Kh, const u16* __restrict__ Vh, const float* __restrict__ qnw, int pos0, int seq, float negBl2, char* lds) {
  int tid = threadIdx.x; asm volatile("" : "+v"(tid));
  const int wid = __builtin_amdgcn_readfirstlane(tid >> 6), lane = tid & 63, r32 = lane & 31, hi = lane >> 5;
  u16* V_lds = (u16*)lds; u16* K_lds = (u16*)(lds + RING * SHM_V);
  float* ws = (float*)(lds + WS_OFF) + wid * 64; float* li_l = ws;
  float l_reg = 0; f32x16 o[4] = {}; bf16x8 qr[8];
  int kgo[2], vgo[2];
#pragma unroll
  for (int i = 0; i < 2; ++i) { const int a = i * 8192 + tid * 16;
    { const int row = a >> 8, cb = (a & 255) ^ ((row & 15) << 4); kgo[i] = row * LDK + (cb >> 1); }
    { const int t = a >> 9, within = (a & 511) >> 1, kk = ((t >> 2) << 3) | (within >> 5), c = (t & 3) * 32 + (within & 31); vgo[i] = kk * LDK + c; } }
  LAS unsigned char* ldsa = (LAS unsigned char*)lds;
#define DMA_K(t) do { const u16* kt_ = Kh + (size_t)(t) * (KVBLK * LDK); LAS unsigned char* d_ = ldsa + RING * SHM_V + ((t) & 3) * SHM_K + wid * 1024; \
    __builtin_amdgcn_global_load_lds((const unsigned*)(kt_ + kgo[0]), (LAS unsigned*)d_, 16, 0, 0); __builtin_amdgcn_global_load_lds((const unsigned*)(kt_ + kgo[1]), (LAS unsigned*)(d_ + 8192), 16, 0, 0); } while (0)
#define DMA_V(t) do { const u16* vt_ = Vh + (size_t)(t) * (KVBLK * LDK); LAS unsigned char* d_ = ldsa + ((t) & 3) * SHM_V + wid * 1024; \
    __builtin_amdgcn_global_load_lds((const unsigned*)(vt_ + vgo[0]), (LAS unsigned*)d_, 16, 0, 0); __builtin_amdgcn_global_load_lds((const unsigned*)(vt_ + vgo[1]), (LAS unsigned*)(d_ + 8192), 16, 0, 0); } while (0)
#define LANDED() do { asm volatile("s_waitcnt vmcnt(0)" ::: "memory"); __syncthreads(); } while (0)
#define KSL(t) ((u16*)((char*)K_lds + ((t) & 3) * SHM_K))
#define VSL(t) (vb0 + ((t) & 3) * (int)SHM_V)
  DMA_K(0); DMA_V(0); DMA_K(1); DMA_K(2); DMA_V(1);
  {
    int hl = hi; asm volatile("" : "+v"(hl));
    const u16* Qw = Qb + (long)(wid * QBLK + r32) * LDQ + hi * 8;
    u32x4 raw[8];
#pragma unroll
    for (int d0 = 0; d0 < 8; ++d0) raw[d0] = *reinterpret_cast<const u32x4*>(Qw + d0 * 16);
    float ss = 0.f;
#pragma unroll
    for (int d0 = 0; d0 < 8; ++d0)
#pragma unroll
      for (int e = 0; e < 4; ++e) { const float a = bflo(raw[d0][e]), b = bfhi(raw[d0][e]); ss += a * a + b * b; }
    { auto rr = __builtin_amdgcn_permlane32_swap(__float_as_uint(ss), __float_as_uint(ss), false, false); ss = __uint_as_float(rr[0]) + __uint_as_float(rr[1]); }
    const float rstd = (SHIFT ? 1.0f : SCALE * 1.4426950408889634f) / sqrtf(ss * (1.0f / 128.0f) + EPS);
    const int pos = pos0 + wid * QBLK + r32; const float prow = (float)(pos >> 6), pcol = (float)(pos & 63);
#pragma unroll
    for (int d0 = 0; d0 < 8; ++d0) {
      const f32x4 w0 = *reinterpret_cast<const f32x4*>(qnw + d0 * 16 + hl * 8), w1 = *reinterpret_cast<const f32x4*>(qnw + d0 * 16 + hl * 8 + 4);
      const float wv[8] = {w0[0], w0[1], w0[2], w0[3], w1[0], w1[1], w1[2], w1[3]};
      u32x4 wq;
#pragma unroll
      for (int e = 0; e < 4; ++e) {
        const int fi = (d0 & 3) * 8 + hl * 4 + e;
        const float inv = exp2f(-(float)fi * 0.41524101186092029f);
        const float ang = (d0 < 4 ? prow : pcol) * inv; const float sn = __sinf(ang), cs = __cosf(ang);
        const float x0 = bflo(raw[d0][e]) * rstd * wv[2 * e], x1 = bfhi(raw[d0][e]) * rstd * wv[2 * e + 1];
        wq[e] = cvtpk(x0 * cs - x1 * sn, x0 * sn + x1 * cs); }
      qr[d0] = *reinterpret_cast<bf16x8*>(&wq); }
  }
  const int vb0 = (int)(uintptr_t)V_lds + v_rd_base(lane);
  f32x16 pA0, pA1, pB0, pB1; bf16x8 pa0, pa1, pa2, pa3; const int NT = seq / KVBLK;
  LANDED();
  qkt(pA0, pA1, KSL(0), qr, r32, hi); partialSM<SHIFT>(pA0, pA1, negBl2);
  float lA = 0.f, lB = 0.f; u32x4 w0, w1, w2;
#pragma unroll
  for (int r = 0; r < 15; ++r) lA += pA0[r];
  VFrag vf;
  DmaCtx dc{Kh, Vh, kgo[0], kgo[1], vgo[0], vgo[1], ldsa, wid, 0, NT};
  for (int s = 1; s + 1 < NT; s += 2) {
    LANDED();
    dc.s = s;
    SBAR(); stepA(pB0, pB1, KSL(s), qr, r32, hi, pA0, pA1, lA, w0, w1, w2, vf, VSL(s - 1)); SBAR();
    stepB<SHIFT, true>(o, VSL(s - 1), w0, w1, w2, pA1, vf, pB0, pB1, lA, lB, negBl2, dc);
    SBAR(); stepA(pA0, pA1, KSL(s + 1), qr, r32, hi, pB0, pB1, lA, w0, w1, w2, vf, VSL(s)); SBAR();
    stepB<SHIFT, false>(o, VSL(s), w0, w1, w2, pB1, vf, pA0, pA1, lA, lB, negBl2, dc);
  }
  LANDED();
  SBAR(); stepA(pB0, pB1, KSL(NT - 1), qr, r32, hi, pA0, pA1, lA, w0, w1, w2, vf, VSL(NT - 2)); SBAR();
  stepB<SHIFT, false>(o, VSL(NT - 2), w0, w1, w2, pA1, vf, pB0, pB1, lA, lB, negBl2, dc);
  l_reg = lA + lB;
  finish_last(pB0, pB1, l_reg, pa0, pa1, pa2, pa3); SBAR();
  pv_d0(o, VSL(NT - 1), pa0, pa1, pa2, pa3);
  { auto rr = __builtin_amdgcn_permlane32_swap(__float_as_uint(l_reg), __float_as_uint(l_reg), false, false); l_reg = __uint_as_float(rr[0]) + __uint_as_float(rr[1]); }
  if (hi == 0) li_l[r32] = l_reg; asm volatile("s_waitcnt lgkmcnt(0)" ::: "memory");
  float rli[16];
#pragma unroll
  for (int r = 0; r < 16; ++r) rli[r] = __builtin_amdgcn_rcpf(li_l[crow(r, hi)]);
  u16* Ow = Qb + (long)(wid * QBLK) * LDQ;
#pragma unroll
  for (int r = 0; r < 16; ++r) { const int oo = crow(r, hi) * LDQ + r32;
    for (int d0 = 0; d0 < 4; ++d0) Ow[oo + d0 * 32] = (u16)(cvtpk(o[d0][r] * rli[r], 0.f) & 0xffffu); }
  __syncthreads();
#undef DMA_K
#undef DMA_V
#undef LANDED
#undef KSL
#undef VSL
}
#undef PIN
#undef MF32
#undef VF_RD2
#undef VF_PK
#undef VF_RDF
#undef VF_PKF
#undef BC8
#undef PK4F
#undef KSWZ
#undef SBAR
}

namespace hg {
typedef short bf16x8 __attribute__((ext_vector_type(8)));
typedef float f32x4 __attribute__((ext_vector_type(4)));
typedef unsigned u32x4 __attribute__((ext_vector_type(4)));
constexpr int L_TOT = 0, L_VT = 8192, L_QT = 24576, L_QB = 40960, L_KT = 57344, L_P = 122880;
constexpr int L_RED = 0, L_RSTD = 2048, L_OUT = L_KT;
__device__ __forceinline__ int sidx(int gc, int h, int dir) { return (gc * 16 + h) * 2 + dir; }
__device__ __forceinline__ int off256(int row, int chunk) { return row * 256 + ((chunk ^ (row & 7)) << 4); }
__device__ __forceinline__ int off128(int row, int chunk) { return row * 128 + ((chunk ^ (row & 7)) << 4); }
__device__ __forceinline__ float h2f_lo(unsigned w) { f16x2_t h = __builtin_bit_cast(f16x2_t, w); return (float)h[0]; }
__device__ __forceinline__ float h2f_hi(unsigned w) { f16x2_t h = __builtin_bit_cast(f16x2_t, w); return (float)h[1]; }

__device__ __forceinline__ void gate_local(const unsigned (&zr)[8], const float* lbp, int cp, int tg, int dir, LAS unsigned char* lds, float (&kk)[8][2], float (&p)[8][2]) {
    float oml[2];
#pragma unroll
    for (int e = 0; e < 2; ++e) oml[e] = 1.0f - sigm(lbp[2 * cp + e] - lbp[HGW + 2 * cp + e]);
    float lf[8][2];
#pragma unroll
    for (int j = 0; j < 8; ++j)
#pragma unroll
        for (int e = 0; e < 2; ++e) { const float z = e ? h2f_hi(zr[j]) : h2f_lo(zr[j]); const float k1 = oml[e] * __builtin_amdgcn_rcpf(1.0f + __expf(z)); kk[j][e] = k1; lf[j][e] = __logf(1.0f - k1); }
#pragma unroll
    for (int e = 0; e < 2; ++e) { float run = 0.f;
        if (dir == 0) {
#pragma unroll
            for (int j = 0; j < 8; ++j) { run += lf[j][e]; p[j][e] = run; } }
        else {
#pragma unroll
            for (int j = 7; j >= 0; --j) { run += lf[j][e]; p[j][e] = run; } }
        ((LAS float*)(lds + L_TOT))[(dir * 8 + tg) * 128 + 2 * cp + e] = run; }
}
__device__ __forceinline__ void gate_global(int cp, int tg, int dir, LAS unsigned char* lds, float (&p)[8][2], float (&sub)[4][2], float (&R)[2], float (&Tot)[2]) {
    const LAS float* T = (const LAS float*)(lds + L_TOT) + dir * 8 * 128 + 2 * cp;
    float t8[8][2];
#pragma unroll
    for (int g = 0; g < 8; ++g) { const f32x2_t v = *(const LAS f32x2_t*)(T + g * 128); t8[g][0] = v.x; t8[g][1] = v.y; }
    const int I = tg >> 1; const bool second = dir ? ((tg & 1) == 0) : ((tg & 1) == 1);
#pragma unroll
    for (int e = 0; e < 2; ++e) {
#pragma unroll
        for (int i2 = 0; i2 < 4; ++i2) sub[i2][e] = t8[2 * i2][e] + t8[2 * i2 + 1][e];
        float partner = 0.f;
#pragma unroll
        for (int g = 0; g < 8; ++g) partner = (g == (tg ^ 1)) ? t8[g][e] : partner;
        const float add = second ? partner : 0.f;
#pragma unroll
        for (int j = 0; j < 8; ++j) p[j][e] += add;
        float r = 0.f;
#pragma unroll
        for (int i2 = 0; i2 < 4; ++i2) { const bool before = dir ? (i2 > I) : (i2 < I); r += before ? sub[i2][e] : 0.f; }
        R[e] = r; Tot[e] = (sub[0][e] + sub[1][e]) + (sub[2][e] + sub[3][e]); }
}

struct APre { unsigned zf[8], zb[8]; };
__device__ __forceinline__ void pass_a_load(APre& p, int gc, int h, const u16* ZF, const u16* ZB, int tid) {
    const int cp = tid & 63, tg = __builtin_amdgcn_readfirstlane(tid >> 6);
    const size_t row0 = (size_t)(gc >= 128 ? T0 + (gc - 128) * 64 : gc * 64);
    const size_t rowoff = (row0 + 8 * tg) * HGW + h * 128 + 2 * cp;
#pragma unroll
    for (int j = 0; j < 8; ++j) { p.zf[j] = *(const unsigned*)(ZF + rowoff + (size_t)j * HGW); p.zb[j] = *(const unsigned*)(ZB + rowoff + (size_t)j * HGW); }
}
__device__ __forceinline__ void pass_a_item(APre& pre, int ngc, int nh, bool has_next, int gc, int h, const u16* ZF, const u16* ZB, const u16* HI, const float* lbf, const float* lbb, u16* ST, float* DC, LAS unsigned char* lds, int tid) {
    const int cp = tid & 63, tg = __builtin_amdgcn_readfirstlane(tid >> 6), lane = tid & 63, fr = lane & 15, fq = lane >> 4, w = tg;
    const size_t row0 = (size_t)(gc >= 128 ? T0 + (gc - 128) * 64 : gc * 64);
    const size_t rowoff = (row0 + 8 * tg) * HGW + h * 128 + 2 * cp;
    unsigned vr[8];
#pragma unroll
    for (int j = 0; j < 8; ++j) vr[j] = *(const unsigned*)(HI + rowoff + (size_t)j * HGW);
    unsigned zf[8], zb[8];
#pragma unroll
    for (int j = 0; j < 8; ++j) { zf[j] = pre.zf[j]; zb[j] = pre.zb[j]; }
    float kk[2][8][2], p[2][8][2];
    gate_local(zf, lbf + h * 128, cp, tg, 0, lds, kk[0], p[0]);
    gate_local(zb, lbb + h * 128, cp, tg, 1, lds, kk[1], p[1]);
#pragma unroll
    for (int e = 0; e < 2; ++e) { u32x4 o;
        o.x = e ? ((vr[0] >> 16) | (vr[1] & 0xffff0000u)) : ((vr[0] & 0xffffu) | (vr[1] << 16)); o.y = e ? ((vr[2] >> 16) | (vr[3] & 0xffff0000u)) : ((vr[2] & 0xffffu) | (vr[3] << 16));
        o.z = e ? ((vr[4] >> 16) | (vr[5] & 0xffff0000u)) : ((vr[4] & 0xffffu) | (vr[5] << 16)); o.w = e ? ((vr[6] >> 16) | (vr[7] & 0xffff0000u)) : ((vr[6] & 0xffffu) | (vr[7] << 16));
        *(LAS u32x4*)(lds + L_VT + off128(2 * cp + e, tg)) = o; }
    __syncthreads();
#pragma unroll
    for (int dir = 0; dir < 2; ++dir) {
        float sub[4][2], R[2], Tot[2];
        gate_global(cp, tg, dir, lds, p[dir], sub, R, Tot);
#pragma unroll
        for (int e = 0; e < 2; ++e) { float k4[8];
#pragma unroll
            for (int j = 0; j < 8; ++j) k4[j] = kk[dir][j][e] * __expf(Tot[e] - R[e] - p[dir][j][e]);
            u32x4 o; o.x = pkbf(k4[0], k4[1]); o.y = pkbf(k4[2], k4[3]); o.z = pkbf(k4[4], k4[5]); o.w = pkbf(k4[6], k4[7]);
            *(LAS u32x4*)(lds + L_KT + dir * 16384 + off128(2 * cp + e, tg)) = o;
            if (tg == 0) DC[(size_t)sidx(gc, h, dir) * 128 + 2 * cp + e] = __expf(Tot[e]); }
    }
    __syncthreads();
    if (has_next) pass_a_load(pre, ngc, nh, ZF, ZB, tid);
#pragma unroll
    for (int dir = 0; dir < 2; ++dir) {
        f32x4 acc[8];
#pragma unroll
        for (int n = 0; n < 8; ++n) acc[n] = (f32x4){0.f, 0.f, 0.f, 0.f};
#pragma unroll
        for (int ks = 0; ks < 2; ++ks) { const bf16x8 a = *(const LAS bf16x8*)(lds + L_KT + dir * 16384 + off128(16 * w + fr, 4 * ks + fq));
#pragma unroll
            for (int n = 0; n < 8; ++n) { const bf16x8 b = *(const LAS bf16x8*)(lds + L_VT + off128(16 * n + fr, 4 * ks + fq)); acc[n] = __builtin_amdgcn_mfma_f32_16x16x32_bf16(a, b, acc[n], 0, 0, 0); } }
        u16* st = ST + (size_t)sidx(gc, h, dir) * 16384 + 16 * w + 4 * fq;
#pragma unroll
        for (int n = 0; n < 8; ++n) { u32x2_t o; o.x = pkbf(acc[n][0], acc[n][1]); o.y = pkbf(acc[n][2], acc[n][3]); *(u32x2_t*)(st + (16 * n + fr) * 128) = o; }
    }
    __syncthreads();
}

__device__ __forceinline__ void pass_b_item(int item, u16* ST, const float* DC, int tid) {
    const int chain = item >> 2, quarter = item & 3, seq = (chain >> 5) ^ 1, dir = (chain >> 4) & 1, h = chain & 15;
    const int n = seq ? 256 : 128, gc0 = seq ? 128 : 0, e16 = quarter * 512 + tid, k0 = (e16 & 15) * 8;
    float S[8];
#pragma unroll
    for (int i = 0; i < 8; ++i) S[i] = 0.f;
    for (int s0 = 0; s0 < n; s0 += 4) {
        u32x4 d[4]; f32x4 da[4], db[4]; u32x4* sp[4];
#pragma unroll
        for (int u = 0; u < 4; ++u) { const int c = dir ? n - 1 - (s0 + u) : s0 + u; const size_t si = (size_t)sidx(gc0 + c, h, dir);
            sp[u] = (u32x4*)(ST + si * 16384) + e16; d[u] = *sp[u]; da[u] = *(const f32x4*)(DC + si * 128 + k0); db[u] = *(const f32x4*)(DC + si * 128 + k0 + 4); }
#pragma unroll
        for (int u = 0; u < 4; ++u) {
            u32x4 o; o.x = pkbf(S[0], S[1]); o.y = pkbf(S[2], S[3]); o.z = pkbf(S[4], S[5]); o.w = pkbf(S[6], S[7]); *sp[u] = o;
            S[0] = da[u][0] * S[0] + bflo(d[u].x); S[1] = da[u][1] * S[1] + bfhi(d[u].x); S[2] = da[u][2] * S[2] + bflo(d[u].y); S[3] = da[u][3] * S[3] + bfhi(d[u].y);
            S[4] = db[u][0] * S[4] + bflo(d[u].z); S[5] = db[u][1] * S[5] + bfhi(d[u].z); S[6] = db[u][2] * S[6] + bflo(d[u].w); S[7] = db[u][3] * S[7] + bfhi(d[u].w); }
    }
}

struct CPre { unsigned zf[8]; };
__device__ __forceinline__ void pass_c_load(CPre& p, int gc, int h, const u16* ZF, int tid) {
    const int cp = tid & 63, tg = __builtin_amdgcn_readfirstlane(tid >> 6);
    const size_t row0 = (size_t)(gc >= 128 ? T0 + (gc - 128) * 64 : gc * 64);
    const size_t rowoff = (row0 + 8 * tg) * HGW + h * 128 + 2 * cp;
#pragma unroll
    for (int j = 0; j < 8; ++j) p.zf[j] = *(const unsigned*)(ZF + rowoff + (size_t)j * HGW);
}
__device__ __forceinline__ void pass_c_item(CPre& pre, int ngc, int nh, bool has_next, int gc, int h, u16* HQ, const u16* ZF, const u16* ZB, const u16* HI, const u16* HOG, const float* lbf, const float* lbb, const float* hgw,
                                            const u16* ST, LAS unsigned char* lds, int tid) {
    const int cp = tid & 63, tg = __builtin_amdgcn_readfirstlane(tid >> 6), lane = tid & 63, fr = lane & 15, fq = lane >> 4, w = tg;
    const size_t row0 = (size_t)(gc >= 128 ? T0 + (gc - 128) * 64 : gc * 64);
    const size_t rowoff = (row0 + 8 * tg) * HGW + h * 128 + 2 * cp;
    unsigned qr[8], vr[8], zz[2][8];
#pragma unroll
    for (int j = 0; j < 8; ++j) { zz[0][j] = pre.zf[j]; vr[j] = *(const unsigned*)(HI + rowoff + (size_t)j * HGW); qr[j] = *(const unsigned*)(HQ + rowoff + (size_t)j * HGW); zz[1][j] = *(const unsigned*)(ZB + rowoff + (size_t)j * HGW); }
    f32x4 oacc[4];
#pragma unroll
    for (int mi = 0; mi < 4; ++mi) oacc[mi] = (f32x4){0.f, 0.f, 0.f, 0.f};
#pragma unroll 1
    for (int dir = 0; dir < 2; ++dir) {
        bf16x8 sf[4];
#pragma unroll
        for (int ks = 0; ks < 4; ++ks) sf[ks] = *(const bf16x8*)(ST + (size_t)sidx(gc, h, dir) * 16384 + (16 * w + fr) * 128 + 32 * ks + 8 * fq);
        float kk[8][2], p[8][2];
        if (dir == 0) gate_local(zz[0], lbf + h * 128, cp, tg, 0, lds, kk, p); else gate_local(zz[1], lbb + h * 128, cp, tg, 1, lds, kk, p);
        if (dir == 0) {
#pragma unroll
    for (int e = 0; e < 2; ++e) { u32x4 o;
        o.x = e ? ((vr[0] >> 16) | (vr[1] & 0xffff0000u)) : ((vr[0] & 0xffffu) | (vr[1] << 16)); o.y = e ? ((vr[2] >> 16) | (vr[3] & 0xffff0000u)) : ((vr[2] & 0xffffu) | (vr[3] << 16));
        o.z = e ? ((vr[4] >> 16) | (vr[5] & 0xffff0000u)) : ((vr[4] & 0xffffu) | (vr[5] << 16)); o.w = e ? ((vr[6] >> 16) | (vr[7] & 0xffff0000u)) : ((vr[6] & 0xffffu) | (vr[7] << 16));
        *(LAS u32x4*)(lds + L_VT + off128(2 * cp + e, tg)) = o; }
        }
        __syncthreads();
        float sub[4][2], R[2], Tot[2];
        gate_global(cp, tg, dir, lds, p, sub, R, Tot);
        const int I = tg >> 1;
        float eR[2], F[4][2];
#pragma unroll
        for (int e = 0; e < 2; ++e) { eR[e] = __expf(R[e]);
#pragma unroll
            for (int Ir = 0; Ir < 4; ++Ir) { float d = 0.f;
#pragma unroll
                for (int i2 = 0; i2 < 4; ++i2) { const bool between = dir ? (i2 <= I && i2 > Ir) : (i2 >= I && i2 < Ir); d += between ? sub[i2][e] : 0.f; }
                const bool after = dir ? (Ir < I) : (Ir > I);
                F[Ir][e] = (Ir == I) ? 1.0f : (after ? __expf(d) : 0.0f); } }
#pragma unroll
        for (int j = 0; j < 8; ++j) { const int i = 8 * tg + j;
            const float q0 = bflo(qr[j]), q1 = bfhi(qr[j]);
            const float ea0 = __expf(p[j][0]), ea1 = __expf(p[j][1]);
            const float qt0 = q0 * ea0, qt1 = q1 * ea1;
            *(LAS unsigned*)(lds + L_QT + off256(i, cp >> 2) + (cp & 3) * 4) = pkbf(qt0, qt1);
            *(LAS unsigned*)(lds + L_QB + off256(i, cp >> 2) + (cp & 3) * 4) = pkbf(qt0 * eR[0], qt1 * eR[1]);
            const float kd0 = kk[j][0] * __expf(fminf(-p[j][0], 80.f)), kd1 = kk[j][1] * __expf(fminf(-p[j][1], 80.f));
#pragma unroll
            for (int Ir = 0; Ir < 4; ++Ir) *(LAS unsigned*)(lds + L_KT + Ir * 16384 + off256(i, cp >> 2) + (cp & 3) * 4) = pkbf(kd0 * F[Ir][0], kd1 * F[Ir][1]); }
        __syncthreads();
        { const int Ib = w >> 1;
#pragma unroll
          for (int jj = 0; jj < 2; ++jj) { const int J = 2 * (w & 1) + jj; f32x4 sc = (f32x4){0.f, 0.f, 0.f, 0.f};
#pragma unroll
            for (int ks = 0; ks < 4; ++ks) { const bf16x8 a = *(const LAS bf16x8*)(lds + L_QT + off256(16 * Ib + fr, 4 * ks + fq));
                const bf16x8 b = *(const LAS bf16x8*)(lds + L_KT + Ib * 16384 + off256(16 * J + fr, 4 * ks + fq)); sc = __builtin_amdgcn_mfma_f32_16x16x32_bf16(a, b, sc, 0, 0, 0); }
#pragma unroll
            for (int r = 0; r < 4; ++r) { const int il = 4 * fq + r; float v = sc[r];
                if (J == Ib) { const bool keep = dir ? (fr >= il) : (fr <= il); v = keep ? v : 0.f; }
                const int row = 16 * Ib + il, col = 16 * J + fr;
                *(LAS u16*)(lds + L_P + off128(row, col >> 3) + (col & 7) * 2) = (u16)(pkbf(v, 0.f) & 0xffffu); } } }
        __syncthreads();
#pragma unroll
        for (int ks = 0; ks < 4; ++ks) { const bf16x8 b = sf[ks];
#pragma unroll
            for (int mi = 0; mi < 4; ++mi) { const bf16x8 a = *(const LAS bf16x8*)(lds + L_QB + off256(16 * mi + fr, 4 * ks + fq)); oacc[mi] = __builtin_amdgcn_mfma_f32_16x16x32_bf16(a, b, oacc[mi], 0, 0, 0); } }
#pragma unroll
        for (int ks = 0; ks < 2; ++ks) { const bf16x8 b = *(const LAS bf16x8*)(lds + L_VT + off128(16 * w + fr, 4 * ks + fq));
#pragma unroll
            for (int mi = 0; mi < 4; ++mi) { const bf16x8 a = *(const LAS bf16x8*)(lds + L_P + off128(16 * mi + fr, 4 * ks + fq)); oacc[mi] = __builtin_amdgcn_mfma_f32_16x16x32_bf16(a, b, oacc[mi], 0, 0, 0); } }
        __syncthreads();
    }
#pragma unroll
    for (int mi = 0; mi < 4; ++mi)
#pragma unroll
        for (int r = 0; r < 4; ++r) { float sq = oacc[mi][r] * oacc[mi][r];
            sq += __shfl_xor(sq, 1); sq += __shfl_xor(sq, 2); sq += __shfl_xor(sq, 4); sq += __shfl_xor(sq, 8);
            if (fr == 0) ((LAS float*)(lds + L_RED))[w * 64 + 16 * mi + 4 * fq + r] = sq; }
    __syncthreads();
    if (has_next) pass_c_load(pre, ngc, nh, ZF, tid);
    u32x4 hogr[2];
#pragma unroll
    for (int c2 = 0; c2 < 2; ++c2) { const int id = tid + 512 * c2; hogr[c2] = *(const u32x4*)(HOG + (row0 + (id >> 4)) * HGW + h * 128 + (id & 15) * 8); }
    if (tid < 64) { float t = 0.f;
#pragma unroll
        for (int ww = 0; ww < 8; ++ww) t += ((const LAS float*)(lds + L_RED))[ww * 64 + tid];
        ((LAS float*)(lds + L_RSTD))[tid] = 1.0f / sqrtf(t * (1.0f / 128.0f) + EPS); }
    __syncthreads();
    { const float wv = hgw[h * 128 + 16 * w + fr];
#pragma unroll
      for (int mi = 0; mi < 4; ++mi)
#pragma unroll
        for (int r = 0; r < 4; ++r) { const int i = 16 * mi + 4 * fq + r; ((LAS float*)(lds + L_OUT))[i * 128 + 16 * w + fr] = oacc[mi][r] * ((const LAS float*)(lds + L_RSTD))[i] * wv; } }
    __syncthreads();
#pragma unroll
    for (int c2 = 0; c2 < 2; ++c2) { const int id = tid + 512 * c2, i = id >> 4, vc = (id & 15) * 8;
        const f32x4 y0 = *(const LAS f32x4*)(lds + L_OUT + (i * 128 + vc) * 4), y1 = *(const LAS f32x4*)(lds + L_OUT + (i * 128 + vc + 4) * 4);
        const size_t go = (row0 + i) * HGW + h * 128 + vc; const u32x4 g = hogr[c2];
        u32x4 o; o.x = pkbf(y0[0] * bflo(g.x), y0[1] * bfhi(g.x)); o.y = pkbf(y0[2] * bflo(g.y), y0[3] * bfhi(g.y)); o.z = pkbf(y1[0] * bflo(g.z), y1[1] * bfhi(g.z)); o.w = pkbf(y1[2] * bflo(g.w), y1[3] * bfhi(g.w));
        *(u32x4*)(HQ + go) = o; }
    __syncthreads();
}
}

__device__ __forceinline__ void tr_item(const float* W, int K, int N, u16* WT, LAS float* scr, int item, int lane, bool gu) {
    const int nblk = N / 32, kb = item / nblk, nb = item % nblk, k0 = 64 * kb, n0 = 32 * nb;
    float wv_[32];
#pragma unroll
    for (int i = 0; i < 32; ++i) wv_[i] = W[(size_t)(k0 + 2 * i + (lane >> 5)) * N + n0 + (lane & 31)];
#pragma unroll
    for (int i = 0; i < 32; ++i) scr[(2 * i + (lane >> 5)) * 33 + (lane & 31)] = wv_[i];
    LDS_WAIT(); asm volatile("" ::: "memory");
    int r0 = n0;
    if (gu) { const int isu = n0 >= DFF ? 1 : 0, nn = n0 - isu * DFF; r0 = (nn >> 7) * 256 + isu * 128 + (nn & 127); }
    const int c = lane & 7;
#pragma unroll
    for (int j = 0; j < 4; ++j) { const int n = (lane >> 3) + 8 * j; const LAS float* s = scr + (8 * c) * 33 + n;
        v4u o; o.x = pkbf(s[0 * 33], s[1 * 33]); o.y = pkbf(s[2 * 33], s[3 * 33]); o.z = pkbf(s[4 * 33], s[5 * 33]); o.w = pkbf(s[6 * 33], s[7 * 33]);
        *(GAS v4u*)(WT + (size_t)(r0 + n) * K + k0 + 8 * c) = o; }
    LDS_WAIT(); asm volatile("" ::: "memory");
}
__device__ __forceinline__ void rms_row(const float* xrow, const float* w, u16* ob, float* of, int lane) {
    const f32x4* xr = (const f32x4*)xrow + lane; const f32x4* wr = (const f32x4*)w + lane;
    f32x4 v[16], wv[16]; float s = 0.f;
#pragma unroll
    for (int j = 0; j < 16; ++j) v[j] = xr[64 * j];
#pragma unroll
    for (int j = 0; j < 16; ++j) wv[j] = wr[64 * j];
#pragma unroll
    for (int j = 0; j < 16; ++j) s += (v[j].x * v[j].x + v[j].y * v[j].y) + (v[j].z * v[j].z + v[j].w * v[j].w);
    const float rstd = 1.0f / sqrtf(wave_sum(s) * (1.0f / DM) + EPS);
#pragma unroll
    for (int j = 0; j < 16; ++j) { const f32x4 o = (v[j] * rstd) * wv[j];
        if (ob) { u32x2_t p; p.x = pkbf(o.x, o.y); p.y = pkbf(o.z, o.w); ((u32x2_t*)ob)[lane + 64 * j] = p; }
        else ((f32x4*)of)[lane + 64 * j] = o; }
}
template <bool ADD> __device__ __forceinline__ void rms_row_b16(const u16* xrow, const u16* arow, const float* w, u16* ob, float* of, int lane) {
    const pg8::u32x4* xr = (const pg8::u32x4*)xrow + lane; const pg8::u32x4* ar = (const pg8::u32x4*)arow + lane; const f32x4* wr = (const f32x4*)w + 2 * lane;
    pg8::u32x4 v[8], va[8]; f32x4 wv[8][2]; float s = 0.f;
#pragma unroll
    for (int j = 0; j < 8; ++j) v[j] = xr[64 * j];
    if constexpr (ADD) {
#pragma unroll
        for (int j = 0; j < 8; ++j) va[j] = ar[64 * j]; }
#pragma unroll
    for (int j = 0; j < 8; ++j) { wv[j][0] = wr[128 * j]; wv[j][1] = wr[128 * j + 1]; }
    float f[8][8];
#pragma unroll
    for (int j = 0; j < 8; ++j) { f[j][0] = bflo(v[j].x); f[j][1] = bfhi(v[j].x); f[j][2] = bflo(v[j].y); f[j][3] = bfhi(v[j].y); f[j][4] = bflo(v[j].z); f[j][5] = bfhi(v[j].z); f[j][6] = bflo(v[j].w); f[j][7] = bfhi(v[j].w);
        if constexpr (ADD) { f[j][0] += bflo(va[j].x); f[j][1] += bfhi(va[j].x); f[j][2] += bflo(va[j].y); f[j][3] += bfhi(va[j].y); f[j][4] += bflo(va[j].z); f[j][5] += bfhi(va[j].z); f[j][6] += bflo(va[j].w); f[j][7] += bfhi(va[j].w); }
#pragma unroll
        for (int e = 0; e < 8; ++e) s += f[j][e] * f[j][e]; }
    const float rstd = 1.0f / sqrtf(wave_sum(s) * (1.0f / DM) + EPS);
#pragma unroll
    for (int j = 0; j < 8; ++j) { pg8::u32x4 o;
        if (!ob) { f32x4 a = {f[j][0], f[j][1], f[j][2], f[j][3]}, b = {f[j][4], f[j][5], f[j][6], f[j][7]};
            ((f32x4*)of)[2 * (lane + 64 * j)] = (a * rstd) * wv[j][0]; ((f32x4*)of)[2 * (lane + 64 * j) + 1] = (b * rstd) * wv[j][1]; continue; }
        o.x = pkbf(f[j][0] * rstd * wv[j][0].x, f[j][1] * rstd * wv[j][0].y); o.y = pkbf(f[j][2] * rstd * wv[j][0].z, f[j][3] * rstd * wv[j][0].w);
        o.z = pkbf(f[j][4] * rstd * wv[j][1].x, f[j][5] * rstd * wv[j][1].y); o.w = pkbf(f[j][6] * rstd * wv[j][1].z, f[j][7] * rstd * wv[j][1].w);
        ((pg8::u32x4*)ob)[lane + 64 * j] = o; }
}
__device__ __forceinline__ void k_norm_rope(u16* AK, const float* knw, int gw, int NGW, int lane) {
    const float inv = exp2f(-(float)(lane & 31) * 0.41524101186092029f);
    const float w0 = knw[2 * lane], w1 = knw[2 * lane + 1];
    for (int it = gw; it < M * 4; it += NGW) {
        const int m = it >> 2, kvh = it & 3; unsigned* p = (unsigned*)(AK + (size_t)m * KVW + kvh * 128) + lane;
        const unsigned raw = *p; const float a = bflo(raw), b = bfhi(raw);
        const float rstd = 1.0f / sqrtf(wave_sum(a * a + b * b) * (1.0f / 128.0f) + EPS);
        const int pos = m < T0 ? m : m - T0; const float ang = (lane < 32 ? (float)(pos >> 6) : (float)(pos & 63)) * inv;
        const float sn = __sinf(ang), cs = __cosf(ang), x0 = a * rstd * w0, x1 = b * rstd * w1;
        *p = pkbf(x0 * cs - x1 * sn, x0 * sn + x1 * cs);
    }
}
#ifndef GEMM_ALIGN
#define GEMM_ALIGN true
#endif
#ifndef GEMM_SP2
#define GEMM_SP2 true
#endif
#define GEMM_RUN(EPI) pg8::gemm_phase<EPI, pg8::StaticOrder, GEMM_ALIGN, GEMM_SP2>
constexpr int NPH = 12;
constexpr int I_GU = (DM / 64) * (2 * DFF / 32), I_DN = (DFF / 64) * (DM / 32), I_A = (HGW / 64) * (DM / 32), I_O = (DM / 64) * (DM / 32);
#ifndef I_GU_TAIL
#define I_GU_TAIL 28672
#endif
constexpr size_t WS_DC = WS_END, WS_NEED = WS_END + 8 * MiB;
struct Args { const float* in[16]; float* out; unsigned char* ws; int ph_lo, ph_hi; };
__global__ void __launch_bounds__(NWAVES * 64, 2) fwd_kernel(Args args) {
    extern __shared__ __attribute__((aligned(16))) unsigned char lds[];
    LAS unsigned char* ldsl = (LAS unsigned char*)lds;
    volatile LAS unsigned* MISC = (volatile LAS unsigned*)(ldsl + MISC_OFF);
    const int wave = __builtin_amdgcn_readfirstlane((int)threadIdx.x >> 6);
    const int G = gridDim.x; const int bx = blockIdx.x; const int vcu = (G % 8 == 0) ? (bx % 8) * (G / 8) + bx / 8 : bx;
    const int gw = vcu * NWAVES + wave, NGW = G * NWAVES;
    unsigned char* ws = args.ws; unsigned char* dob = (unsigned char*)args.out;
    float* const outp = args.out;
    gu32* ctl = (gu32*)(ws + WS_CTL);
    for (int u = threadIdx.x; u < (LDS_BYTES - 131072) / 4; u += NWAVES * 64) ((LAS unsigned*)(ldsl + 131072))[u] = 0u;
    __syncthreads();
    XcdBarrier bar = xcd_barrier_post((unsigned*)(ctl + CW_BAR), MISC + 8);
    const int lo = args.ph_lo, hi = args.ph_hi;
#define IN(k) (lo <= (k) && (k) < hi)
#define SEAM(k) do { if (IN((k) + 1)) xcd_barrier(bar); } while (0)
#define WIN_t ((u16*)(dol + DO_WIN))
#define Hn ((u16*)(dol + DO_H))
#define WA_t ((u16*)(wsl + WS_WA))
#define WB_t ((u16*)(wsl + WS_WB))
#define WOUT_t ((u16*)(wsl + WS_WOUT))
#define WGU_t ((u16*)(wsl + WS_WGU))
#define WDN_t ((u16*)(wsl + WS_WDN))
#define PHASE_PTRS size_t zof_ = 0; int zph = 0; int tidl_ = threadIdx.x; asm volatile("" : "+s"(zof_), "+s"(zph), "+v"(tidl_)); \
    unsigned char* wsl = ws + zof_; unsigned char* dol = dob + zof_;     \
    const int tid = tidl_, lane = tidl_ & 63; (void)tid; (void)lane
#define INP(k) (args.in[(k) + zph])

    if (IN(0)) { PHASE_PTRS;
        LAS float* scr = (LAS float*)(ldsl + wave * 16384);
        constexpr int I_IN = (DM / 64) * (INW / 32);
        constexpr int NITEMS = I_IN + 2 * I_A + I_O + (I_GU - I_GU_TAIL);
        for (int it = gw; it < NITEMS; it += NGW) {
            int r = it;
            if (r < I_IN) { tr_item(INP(3), DM, INW, WIN_t, scr, r, lane, false); continue; } r -= I_IN;
            if (r < I_A) { tr_item(INP(9), HGW, DM, WA_t, scr, r, lane, false); continue; } r -= I_A;
            if (r < I_A) { tr_item(INP(10), AW, DM, WB_t, scr, r, lane, false); continue; } r -= I_A;
            if (r < I_O) { tr_item(INP(11), DM, DM, WOUT_t, scr, r, lane, false); continue; } r -= I_O;
            tr_item(INP(13), DM, 2 * DFF, WGU_t, scr, I_GU_TAIL + r, lane, true);
        }
        for (int m = gw; m < M; m += NGW) rms_row(m < T0 ? INP(0) + (size_t)m * DM : INP(1) + (size_t)(m - T0) * DM, INP(2), Hn + (size_t)m * DM, nullptr, lane);
        SEAM(0);
    }
    if (IN(1)) { PHASE_PTRS;
        pg8::Gemm g{Hn, WIN_t, M, INW, DM}; pg8::StaticOrder S; S.init(M, INW, G, bx);
        EpiInProj E{wsl};
        GEMM_RUN(EpiInProj)(ldsl, g, S, E);
        { LAS float* scr = (LAS float*)(ldsl + wave * 16384); const bool split = (G == 256); const int w0 = split ? (bx - 128) * NWAVES + wave : bx * NWAVES + wave, nw = split ? 128 * NWAVES : G * NWAVES;
          int tl2_ = threadIdx.x; asm volatile("" : "+v"(tl2_));
          if (!split || bx >= 128) for (int it = w0; it < I_GU_TAIL; it += nw) tr_item(INP(13), DM, 2 * DFF, WGU_t, scr, it, tl2_ & 63, true); }
        SEAM(1);
    }
    if (IN(2)) { PHASE_PTRS;
        k_norm_rope((u16*)(wsl + WS_AK), INP(8), gw, NGW, lane);
        { hg::APre apre;
          if (vcu < 6144) hg::pass_a_load(apre, vcu >> 4, vcu & 15, (const u16*)(wsl + WS_ZF), (const u16*)(wsl + WS_ZB), tid);
          for (int it = vcu; it < 6144; it += G) { const int nit = it + G;
            hg::pass_a_item(apre, nit >> 4, nit & 15, nit < 6144, it >> 4, it & 15, (const u16*)(wsl + WS_ZF), (const u16*)(wsl + WS_ZB), (const u16*)(wsl + WS_HI), INP(4), INP(5), (u16*)dol, (float*)(wsl + WS_DC), ldsl, tid); } }
        SEAM(2);
    }
    if (IN(3)) { PHASE_PTRS;
        for (int item = vcu; item < 256; item += G) hg::pass_b_item(item, (u16*)dol, (const float*)(wsl + WS_DC), tid);
        SEAM(3);
    }
    if (IN(4)) { PHASE_PTRS;
        { hg::CPre cpre;
          if (vcu < 6144) hg::pass_c_load(cpre, vcu >> 4, vcu & 15, (const u16*)(wsl + WS_ZF), tid);
          for (int it = vcu; it < 6144; it += G) { const int nit = it + G;
            hg::pass_c_item(cpre, nit >> 4, nit & 15, nit < 6144, it >> 4, it & 15, (u16*)(wsl + WS_HQ), (const u16*)(wsl + WS_ZF), (const u16*)(wsl + WS_ZB), (const u16*)(wsl + WS_HI), (const u16*)(wsl + WS_HOG), INP(4), INP(5), INP(6), (const u16*)dol, ldsl, tid); } }
        float negBl2;
        { int tl_ = threadIdx.x; asm volatile("" : "+v"(tl_)); const int ln = tl_ & 63;
          const float* qw = INP(7); const float* kw = INP(8); float a = fmaxf(fabsf(qw[2 * ln]), fabsf(qw[2 * ln + 1])), k2 = fmaxf(fabsf(kw[2 * ln]), fabsf(kw[2 * ln + 1]));
#pragma unroll
          for (int o = 1; o < 64; o <<= 1) { a = fmaxf(a, __shfl_xor(a, o)); k2 = fmaxf(k2, __shfl_xor(k2, o)); }
          negBl2 = __uint_as_float(__builtin_amdgcn_readfirstlane(__float_as_uint(-1.4426950408889634f * 11.313708498984761f * a * k2))); }
        u16* AQ = (u16*)(wsl + WS_AQ); const u16* AK = (const u16*)(wsl + WS_AK); const u16* AV = (const u16*)(wsl + WS_AV);
#define ATT_UNITS(SH) for (int idx = vcu; idx < 1536; idx += G) {            \
            int seq, kvh, qh, qb; \
            if (idx < 1024) { seq = 1; kvh = idx >> 8; const int rem = idx & 255; qh = kvh * 4 + (rem >> 6); qb = rem & 63; } \
            else { const int j = idx - 1024; seq = 0; kvh = j >> 7; const int rem = j & 127; qh = kvh * 4 + (rem >> 5); qb = rem & 31; } \
            const size_t rowbase = seq ? T0 : 0; \
            att::attn_unit<SH>(AQ + (rowbase + (size_t)qb * 256) * AW + qh * 128, AK + rowbase * KVW + kvh * 128, AV + rowbase * KVW + kvh * 128, INP(7), qb * 256, seq ? T1 : T0, negBl2, (char*)lds); }
        if (negBl2 >= -60.0f) { ATT_UNITS(false) } else { ATT_UNITS(true) }
#undef ATT_UNITS
        SEAM(4);
    }
    if (IN(5)) { PHASE_PTRS;
        pg8::Gemm g{(const u16*)(wsl + WS_HQ), WA_t, M, DM, HGW}; pg8::StaticOrder S; S.init(M, DM, G, bx);
        EpiGate<false> E{(const u16*)(wsl + WS_GA), nullptr, (u16*)(wsl + WS_T)};
        GEMM_RUN(EpiGate<false>)(ldsl, g, S, E);
        if (IN(6)) { __builtin_amdgcn_fence(__ATOMIC_ACQUIRE, "agent"); asm volatile("s_waitcnt vmcnt(0)" ::: "memory"); __syncthreads(); }
    }
    if (IN(6)) { PHASE_PTRS;
        pg8::Gemm g{(const u16*)(wsl + WS_AQ), WB_t, M, DM, AW}; pg8::StaticOrder S; S.init(M, DM, G, bx);
        EpiGate<true> E{(const u16*)(wsl + WS_GB), (const u16*)(wsl + WS_T), (u16*)(wsl + WS_MERGED)};
        GEMM_RUN(EpiGate<true>)(ldsl, g, S, E);
        SEAM(6);
    }
    if (IN(7)) { PHASE_PTRS;
        pg8::Gemm g{(const u16*)(wsl + WS_MERGED), WOUT_t, M, DM, DM}; pg8::StaticOrder S; S.init(M, DM, G, bx);
        EpiResToB16 E{INP(0), INP(1), (u16*)(wsl + WS_X1B)};
        GEMM_RUN(EpiResToB16)(ldsl, g, S, E);
        SEAM(7);
    }
    if (IN(8)) { PHASE_PTRS;
        for (int m = gw; m < M; m += NGW) rms_row_b16<false>((const u16*)(wsl + WS_X1B) + (size_t)m * DM, nullptr, INP(12), (u16*)(wsl + WS_XN2) + (size_t)m * DM, nullptr, lane);
        SEAM(8);
    }
    if (IN(9)) { PHASE_PTRS;
        pg8::Gemm g{(const u16*)(wsl + WS_XN2), WGU_t, M, 2 * DFF, DM}; pg8::StaticOrder S; S.init(M, 2 * DFF, G, bx);
        EpiSwiGLU E{(u16*)(wsl + WS_ACT)};
        GEMM_RUN(EpiSwiGLU)(ldsl, g, S, E);
        { LAS float* scr = (LAS float*)(ldsl + wave * 16384); const bool split = (G == 256); const int w0 = split ? (bx - 64) * NWAVES + wave : bx * NWAVES + wave, nw = split ? 192 * NWAVES : G * NWAVES;
          int tl2_ = threadIdx.x; asm volatile("" : "+v"(tl2_));
          if (!split || bx >= 64) for (int it = w0; it < I_DN; it += nw) tr_item(INP(14), DFF, DM, WDN_t, scr, it, tl2_ & 63, false); }
        SEAM(9);
    }
    if (IN(10)) { PHASE_PTRS;
        pg8::Gemm g{(const u16*)(wsl + WS_ACT), WDN_t, M, DM, DFF}; pg8::StaticOrder S; S.init(M, DM, G, bx);
        EpiPlainB16 E{(u16*)(wsl + WS_X2B)};
        GEMM_RUN(EpiPlainB16)(ldsl, g, S, E);
        SEAM(10);
    }
    if (IN(11)) { PHASE_PTRS;
        for (int m = gw; m < M; m += NGW) rms_row_b16<true>((const u16*)(wsl + WS_X1B) + (size_t)m * DM, (const u16*)(wsl + WS_X2B) + (size_t)m * DM, INP(15), nullptr, outp + (size_t)m * DM, lane);
    }
#undef IN
#undef SEAM
#undef INP
#undef PHASE_PTRS
#undef WIN_t
#undef Hn
#undef WA_t
#undef WB_t
#undef WOUT_t
#undef WGU_t
#undef WDN_t
}

#ifndef MK_N_LAUNCHES
#define MK_N_LAUNCHES 1
#endif
extern "C" void kernel_launch(void* const* d_in, const int* in_sizes, int n_in, void* d_out, int out_size, void* d_ws, size_t ws_size, hipStream_t stream) {
    static int grid = 0;
    if (grid == 0) {
        if (n_in != 16 || in_sizes[0] != T0 * DM || in_sizes[1] != T1 * DM || out_size != M * DM || ws_size < WS_NEED) {
            fprintf(stderr, "kernel_launch: shape mismatch (n_in %d, out %d, ws %zu); nothing launched\n", n_in, out_size, ws_size); grid = -1; return; }
        int dev = 0, cus = 0, per_cu = 0;
        if (hipGetDevice(&dev) != hipSuccess || hipDeviceGetAttribute(&cus, hipDeviceAttributeMultiprocessorCount, dev) != hipSuccess) { grid = -1; return; }
        if (hipFuncSetAttribute((const void*)fwd_kernel, hipFuncAttributeMaxDynamicSharedMemorySize, LDS_BYTES) != hipSuccess) { fprintf(stderr, "kernel_launch: hipFuncSetAttribute failed\n"); grid = -1; return; }
        if (hipOccupancyMaxActiveBlocksPerMultiprocessor(&per_cu, (const void*)fwd_kernel, NWAVES * 64, LDS_BYTES) != hipSuccess || per_cu < 1) { fprintf(stderr, "kernel_launch: occupancy query says %d\n", per_cu); grid = -1; (void)hipGetLastError(); return; }
        grid = cus;
    }
    if (grid < 0) return;
    if (hipMemsetAsync((char*)d_ws + WS_CTL, 0, CTL_ZERO_BYTES, stream) != hipSuccess) return;
    Args a{};
    for (int i = 0; i < 16; ++i) a.in[i] = (const float*)d_in[i];
    a.out = (float*)d_out; a.ws = (unsigned char*)d_ws;
    if (MK_N_LAUNCHES == 1) { a.ph_lo = 0; a.ph_hi = NPH; hipLaunchKernelGGL(fwd_kernel, dim3(grid), dim3(NWAVES * 64), LDS_BYTES, stream, a); }
    else for (int p = 0; p < NPH; ++p) { a.ph_lo = p; a.ph_hi = p + 1; hipLaunchKernelGGL(fwd_kernel, dim3(grid), dim3(NWAVES * 64), LDS_BYTES, stream, a); }
    const hipError_t le = hipPeekAtLastError();
    if (le != hipSuccess) fprintf(stderr, "kernel_launch: launch failed: %s\n", hipGetErrorName(le));
}
```

```cpp
#include <hip/hip_runtime.h>
#include <cstdio>
#include <cstdint>
namespace pg8 {
#define PG8_LAS __attribute__((address_space(3)))
typedef unsigned short bf16_t;
typedef short bf16x8 __attribute__((ext_vector_type(8)));
typedef float f32x4 __attribute__((ext_vector_type(4)));
typedef unsigned u32x4 __attribute__((ext_vector_type(4)));
constexpr int BM = 256, BK = 64, HALF = 128, HTB = HALF * BK * 2  , STAGE_BYTES = 8 * HTB, NXCD = 8, WGM = 4;

__host__ __device__ __forceinline__ int lds_byte(int r, int c) { const int st = (r >> 4) * 2 + (c >> 5), rr = r & 15, cc = c & 31, ob = rr * 64 + cc * 2; return st * 1024 + (ob ^ (((ob >> 9) & 1) << 5)); }
__host__ __device__ __forceinline__ void stage_rc(int b, int& R, int& C) { const int st = b / 1024, sb = b % 1024, swz = sb ^ (((sb >> 9) & 1) << 5); R = (st >> 1) * 16 + swz / 64; C = (st & 1) * 32 + (swz % 64) / 2; }
__host__ __device__ __forceinline__ int perm32(int rho) { const int n = rho >> 4, i = rho & 15; return 8 * (i >> 2) + 4 * n + (i & 3); }

struct Unit { int pm, pn; };
struct Gemm { const bf16_t* A; const bf16_t* Bt; int M, N, K; };

struct StaticOrder {
    int nM, nN, nwg, G, c, wgm;
    __host__ __device__ void init(int M, int N, int G_, int c_, int wgm_ = WGM) { nM = M / BM; nN = N / BM; nwg = nM * nN; G = G_; c = c_; wgm = wgm_; }
    __host__ __device__ bool next(int i, Unit& u) const {
        const long L = (long)i * G + c; if (L >= nwg) return false;
        int wgid = (int)L; { const int q = nwg / NXCD, r = nwg % NXCD, xcd = wgid % NXCD, off = wgid / NXCD; wgid = (xcd < r ? xcd * (q + 1) : r * (q + 1) + (xcd - r) * q) + off; }
        const int nig = wgm * nN, gid = wgid / nig, fm = gid * wgm, gsz = (nM - fm) < wgm ? (nM - fm) : wgm;
        u.pm = fm + ((wgid % nig) % gsz); u.pn = (wgid % nig) / gsz; return true;
    }
    __device__ __forceinline__ void a_ready(const Unit&) const {}
    __device__ __forceinline__ void done(const Unit&) const {}
};
__device__ __forceinline__ unsigned cvt_pk_bf16(float lo, float hi) { unsigned r; asm volatile("v_cvt_pk_bf16_f32 %0, %1, %2" : "=v"(r) : "v"(lo), "v"(hi)); return r; }
typedef float f32x2 __attribute__((ext_vector_type(2)));
template <class Epi, class Sched, bool ALIGN_EPI = false, bool SP2 = false>
__device__ __forceinline__ void gemm_phase(PG8_LAS unsigned char* lds, const Gemm g, const Sched& S, const Epi& E) {
    const int tid = threadIdx.x, wid = __builtin_amdgcn_readfirstlane(tid >> 6), lane = tid & 63, wr = wid >> 2, wc = wid & 3, fr = lane & 15, fq = lane >> 4;
    const int K = g.K, nt = K / BK;
    unsigned voffA[2], voffB[2];
#pragma unroll
    for (int i = 0; i < 2; ++i) { int R, C; stage_rc(tid * 16 + i * 8192, R, C); const int Rb = Epi::PERM ? ((R & ~31) + perm32(R & 31)) : R;
        voffA[i] = (unsigned)(R * K + C) * 2u; voffB[i] = (unsigned)(Rb * K + C) * 2u; }
    const size_t kstep = (size_t)(BK * 2);
    const size_t hstep = (size_t)HALF * K * 2;
    const size_t tstep = 2 * hstep;
    const unsigned ldsw = (unsigned)wid * 1024u;
    const int aoff = lds_byte(wr * 64 + fr, fq * 8), boff = lds_byte(wc * 32 + fr, fq * 8);
#define PG8_SA(b, h) (((b) * 2 + (h)) * HTB)
#define PG8_SB(b, h) ((4 + (b) * 2 + (h)) * HTB)
#define PG8_STAGE(bufoff, gbase, voff) do { _Pragma("unroll") for (int _i = 0; _i < 2; ++_i) \
        __builtin_amdgcn_global_load_lds((const unsigned*)((const char*)(gbase) + (voff)[_i]), (PG8_LAS unsigned*)(lds + (bufoff) + ldsw + _i * 8192), 16, 0, 0); } while (0)
#define PG8_LDA(dst, b, h) do { _Pragma("unroll") for (int m = 0; m < 4; ++m) _Pragma("unroll") for (int k = 0; k < 2; ++k) dst[m][k] = *(const PG8_LAS bf16x8*)(lds + PG8_SA(b, h) + aoff + m * 2048 + k * 1024); } while (0)
#define PG8_LDB(dst, b, h) do { _Pragma("unroll") for (int n = 0; n < 2; ++n) _Pragma("unroll") for (int k = 0; k < 2; ++k) dst[n][k] = *(const PG8_LAS bf16x8*)(lds + PG8_SB(b, h) + boff + n * 2048 + k * 1024); } while (0)
#define PG8_MMA(ai, bj, At, Bt) do { __builtin_amdgcn_s_setprio(1); _Pragma("unroll") for (int m = 0; m < 4; ++m) _Pragma("unroll") for (int n = 0; n < 2; ++n) _Pragma("unroll") for (int k = 0; k < 2; ++k) \
        acc[ai][bj][m][n] = __builtin_amdgcn_mfma_f32_16x16x32_bf16(Bt[n][k], At[m][k], acc[ai][bj][m][n], 0, 0, 0); __builtin_amdgcn_s_setprio(0); } while (0)
#define PG8_WAIT_V(n) asm volatile("s_waitcnt vmcnt(" #n ")" ::: "memory")
#define PG8_WAIT_L(n) asm volatile("s_waitcnt lgkmcnt(" #n ")" ::: "memory")
#define PG8_BAR __builtin_amdgcn_s_barrier()
#define PG8_SCHED __builtin_amdgcn_sched_barrier(0)
    Unit cur, nxt; int ui = 0;
    if (!S.next(0, cur)) return;
    f32x4 acc[2][2][4][2];
#pragma unroll
    for (int a = 0; a < 2; ++a)
#pragma unroll
        for (int b = 0; b < 2; ++b)
#pragma unroll
            for (int m = 0; m < 4; ++m)
#pragma unroll
                for (int n = 0; n < 2; ++n) acc[a][b][m][n] = (f32x4){0.f, 0.f, 0.f, 0.f};
    bf16x8 At[4][2], B0[2][2], B1[2][2];
    const char* cA = (const char*)g.A + (size_t)cur.pm * tstep; const char* cB = (const char*)g.Bt + (size_t)cur.pn * tstep;
    S.a_ready(cur);
    if constexpr (SP2) {
        PG8_STAGE(PG8_SB(0, 0), cB, voffB); PG8_STAGE(PG8_SB(0, 1), cB + hstep, voffB); PG8_STAGE(PG8_SA(0, 0), cA, voffA); PG8_STAGE(PG8_SA(0, 1), cA + hstep, voffA);
        if (wr == 1) PG8_BAR;
        PG8_WAIT_V(2); PG8_BAR;
        PG8_STAGE(PG8_SB(1, 0), cB + kstep, voffB); PG8_STAGE(PG8_SA(1, 0), cA + kstep, voffA); PG8_STAGE(PG8_SB(1, 1), cB + hstep + kstep, voffB);
        PG8_WAIT_V(6); PG8_BAR;
    } else {
        PG8_STAGE(PG8_SB(0, 0), cB, voffB); PG8_STAGE(PG8_SA(0, 0), cA, voffA); PG8_STAGE(PG8_SB(0, 1), cB + hstep, voffB); PG8_STAGE(PG8_SA(0, 1), cA + hstep, voffA);
        if (wr == 1) PG8_BAR;
        PG8_WAIT_V(4); PG8_BAR;
        PG8_STAGE(PG8_SB(1, 0), cB + kstep, voffB); PG8_STAGE(PG8_SA(1, 0), cA + kstep, voffA); PG8_STAGE(PG8_SB(1, 1), cB + hstep + kstep, voffB);
        PG8_WAIT_V(6); PG8_BAR;
    }
    for (;;) {
        const bool has_next = S.next(ui + 1, nxt);
        const char* nA = has_next ? (const char*)g.A + (size_t)nxt.pm * tstep : cA; const char* nB = has_next ? (const char*)g.Bt + (size_t)nxt.pn * tstep : cB;
        for (int t = 0; t < nt; t += 2) {
            const bool last = (t == nt - 2);
            const char* a1 = cA + (size_t)(t + 1) * kstep;
            const char* a2 = last ? nA : cA + (size_t)(t + 2) * kstep; const char* b2 = last ? nB : cB + (size_t)(t + 2) * kstep;
            const char* a3 = a2 + kstep; const char* b3 = b2 + kstep;
            if (last && has_next) S.a_ready(nxt);
            if constexpr (SP2) {
            PG8_LDB(B0, 0, 0); PG8_LDB(B1, 0, 1); PG8_SCHED; PG8_LDA(At, 0, 0); PG8_STAGE(PG8_SA(1, 1), a1 + hstep, voffA);
            PG8_WAIT_V(8); PG8_WAIT_L(0); PG8_BAR; PG8_MMA(0, 0, At, B0); PG8_MMA(0, 1, At, B1); PG8_BAR; PG8_SCHED;
            PG8_LDA(At, 0, 1); PG8_STAGE(PG8_SB(0, 0), b2, voffB); PG8_STAGE(PG8_SB(0, 1), b2 + hstep, voffB); PG8_STAGE(PG8_SA(0, 0), a2, voffA);
            PG8_WAIT_V(8); PG8_WAIT_L(0); PG8_BAR; PG8_MMA(1, 0, At, B0); PG8_MMA(1, 1, At, B1); PG8_BAR; PG8_SCHED;
            PG8_LDB(B0, 1, 0); PG8_LDB(B1, 1, 1); PG8_SCHED; PG8_LDA(At, 1, 0); PG8_STAGE(PG8_SA(0, 1), a2 + hstep, voffA);
            PG8_WAIT_V(8); PG8_WAIT_L(0); PG8_BAR; PG8_MMA(0, 0, At, B0); PG8_MMA(0, 1, At, B1); PG8_BAR; PG8_SCHED;
            PG8_LDA(At, 1, 1); PG8_STAGE(PG8_SB(1, 0), b3, voffB); PG8_STAGE(PG8_SB(1, 1), b3 + hstep, voffB); PG8_STAGE(PG8_SA(1, 0), a3, voffA);
            PG8_WAIT_V(8); PG8_WAIT_L(0); PG8_BAR; PG8_MMA(1, 0, At, B0); PG8_MMA(1, 1, At, B1); PG8_BAR; PG8_SCHED;
            } else {
            PG8_LDB(B0, 0, 0); PG8_SCHED; PG8_LDA(At, 0, 0); PG8_STAGE(PG8_SA(1, 1), a1 + hstep, voffA);
            PG8_WAIT_L(8); PG8_BAR; PG8_WAIT_L(0); PG8_MMA(0, 0, At, B0); PG8_BAR; PG8_SCHED;
            PG8_LDB(B1, 0, 1); PG8_STAGE(PG8_SB(0, 0), b2, voffB);
            PG8_BAR; PG8_WAIT_L(0); PG8_MMA(0, 1, At, B1); PG8_BAR;
            PG8_LDA(At, 0, 1); PG8_STAGE(PG8_SA(0, 0), a2, voffA);
            PG8_BAR; PG8_WAIT_L(0); PG8_MMA(1, 0, At, B0); PG8_BAR; PG8_SCHED;
            PG8_STAGE(PG8_SB(0, 1), b2 + hstep, voffB);
            PG8_WAIT_V(6); PG8_BAR; PG8_MMA(1, 1, At, B1); PG8_BAR;
            PG8_LDB(B0, 1, 0); PG8_SCHED; PG8_LDA(At, 1, 0); PG8_STAGE(PG8_SA(0, 1), a2 + hstep, voffA);
            PG8_WAIT_L(8); PG8_BAR; PG8_WAIT_L(0); PG8_MMA(0, 0, At, B0); PG8_BAR; PG8_SCHED;
            PG8_LDB(B1, 1, 1); PG8_STAGE(PG8_SB(1, 0), b3, voffB);
            PG8_BAR; PG8_WAIT_L(0); PG8_MMA(0, 1, At, B1); PG8_BAR;
            PG8_LDA(At, 1, 1); PG8_STAGE(PG8_SA(1, 0), a3, voffA);
            PG8_BAR; PG8_WAIT_L(0); PG8_MMA(1, 0, At, B0); PG8_BAR; PG8_SCHED;
            PG8_STAGE(PG8_SB(1, 1), b3 + hstep, voffB);
            PG8_WAIT_V(6); PG8_BAR; PG8_MMA(1, 1, At, B1); PG8_BAR;
            }
        }
        if constexpr (ALIGN_EPI) { if (wr == 0) PG8_BAR; }
        if constexpr (!Epi::AFTER_DRAIN) { E(acc, cur, wr, wc, fr, fq); S.done(cur); }
        if (!has_next) break;
#pragma unroll
        for (int a = 0; a < 2; ++a)
#pragma unroll
            for (int b = 0; b < 2; ++b)
#pragma unroll
                for (int m = 0; m < 4; ++m)
#pragma unroll
                    for (int n = 0; n < 2; ++n) acc[a][b][m][n] = (f32x4){0.f, 0.f, 0.f, 0.f};
        cur = nxt; cA = nA; cB = nB; ++ui;
        if constexpr (ALIGN_EPI) { if (wr == 1) PG8_BAR; }
    }
    PG8_WAIT_V(0);
    if constexpr (!ALIGN_EPI) { if (wr == 0) PG8_BAR; }
    PG8_BAR;
    if constexpr (Epi::AFTER_DRAIN) { E.fused(acc, cur, wr, wc, fr, fq, lds, wid, lane); S.done(cur); }
#undef PG8_SA
#undef PG8_SB
#undef PG8_STAGE
#undef PG8_LDA
#undef PG8_LDB
#undef PG8_MMA
#undef PG8_WAIT_V
#undef PG8_WAIT_L
#undef PG8_BAR
#undef PG8_SCHED
}
}
#define GAS __attribute__((address_space(1)))
#define LAS __attribute__((address_space(3)))
typedef unsigned short bf16;
typedef unsigned v4u __attribute__((ext_vector_type(4)));
typedef float f32x4 __attribute__((ext_vector_type(4)));
typedef short bf16x8 __attribute__((ext_vector_type(8)));
typedef GAS unsigned gu32;
typedef GAS unsigned long long gu64;
#define RLX_AGENT __ATOMIC_RELAXED, __HIP_MEMORY_SCOPE_AGENT
#define LDS_WAIT() asm volatile("s_waitcnt lgkmcnt(0)" ::: "memory")
#define VM_WAIT() asm volatile("s_waitcnt vmcnt(0)" ::: "memory")
__device__ __forceinline__ unsigned long long rt() { return __builtin_amdgcn_s_memrealtime(); }
__device__ __forceinline__ unsigned f2bf(float f) { unsigned u = __builtin_bit_cast(unsigned, f); return (u + 0x7fffu + ((u >> 16) & 1u)) >> 16; }
__device__ __forceinline__ unsigned pk2(float lo, float hi) { return f2bf(lo) | (f2bf(hi) << 16); }
#define XB_TMO      128
#define XB_XCNT(j)  (256  + 64 * (j))
#define XB_XSUB(j)  (1280 + 64 * (j))
#define XB_XGEN(j)  (2304 + 64 * (j))
#define XB_TOP      3328
#define XB_TOPGEN   3392
#define XCD_BAR_WORDS 3456
#define XB_SPIN_CAP (1u << 22)

__device__ __forceinline__ unsigned xb_ld(unsigned* p)              { return __hip_atomic_load(p, __ATOMIC_RELAXED, __HIP_MEMORY_SCOPE_AGENT); }
__device__ __forceinline__ unsigned xb_add(unsigned* p, unsigned v) { return __hip_atomic_fetch_add(p, v, __ATOMIC_RELAXED, __HIP_MEMORY_SCOPE_AGENT); }
__device__ __forceinline__ unsigned xb_xcc_id() { return (unsigned)__builtin_amdgcn_s_getreg((3 << 11) | 20) & 0xFu; }
#define XB_SPIN(cond, bar) do { unsigned _sp = 0; while (cond) { __builtin_amdgcn_s_sleep(1); \
    if ((++_sp & 255u) == 0u) { if (xb_ld(&(bar)[XB_TMO])) break; if (_sp > XB_SPIN_CAP) { atomicAdd(&(bar)[XB_TMO], 1u); break; } } } } while (0)

struct XcdBarrier {
    unsigned* bar; unsigned x;
    volatile LAS unsigned* st;
};

__device__ __forceinline__ XcdBarrier xcd_barrier_post(unsigned* bar, volatile LAS unsigned* st) {
    XcdBarrier b; b.bar = bar; b.x = xb_xcc_id(); b.st = st;
    if (threadIdx.x == 0) (void)xb_add(&bar[XB_XCNT(b.x)], 1u);
    return b;
}
__device__ __forceinline__ void xcd_barrier_complete(unsigned* bar, unsigned x, unsigned& nloc, unsigned& nx) {
    const unsigned G = gridDim.x * gridDim.y * gridDim.z;
    unsigned sum, cnt, mine, sp = 0u;
    for (;;) {
        sum = 0u; cnt = 0u; mine = 0u;
#pragma unroll
        for (unsigned j = 0; j < 16; ++j) { const unsigned c = xb_ld(&bar[XB_XCNT(j)]); sum += c; cnt += (c > 0u) ? 1u : 0u; mine = (j == x) ? c : mine; }
        if (sum == G) break;
        __builtin_amdgcn_s_sleep(1);
        if ((++sp & 255u) == 0u) { if (xb_ld(&bar[XB_TMO])) break; if (sp > XB_SPIN_CAP) { atomicAdd(&bar[XB_TMO], 1u); break; } }
    }
    nloc = mine > 0u ? mine : 1u; nx = cnt > 0u ? cnt : 1u;
}

__device__ __forceinline__ void xcd_barrier(const XcdBarrier& b) {
    asm volatile("s_waitcnt vmcnt(0)" ::: "memory");
    __syncthreads();
    if (threadIdx.x == 0) {
        unsigned* bar = b.bar;
        __builtin_amdgcn_s_waitcnt(0);
        unsigned nloc = b.st[0], nx = b.st[1];
        if (nloc == 0u) { xcd_barrier_complete(bar, b.x, nloc, nx); b.st[0] = nloc; b.st[1] = nx; }
        const unsigned old = xb_add(&bar[XB_XSUB(b.x)], 1u);
        const unsigned gen = old / nloc;
        if (old + 1u == (gen + 1u) * nloc) {
            __builtin_amdgcn_fence(__ATOMIC_RELEASE, "agent");
            asm volatile("s_waitcnt vmcnt(0)" ::: "memory");
            const unsigned og = xb_add(&bar[XB_TOP], 1u);
            const unsigned tg = og / nx;
            if (og + 1u == (tg + 1u) * nx) xb_add(&bar[XB_TOPGEN], 1u);
            else XB_SPIN(xb_ld(&bar[XB_TOPGEN]) == tg, bar);
            __builtin_amdgcn_fence(__ATOMIC_ACQUIRE, "agent");
            xb_add(&bar[XB_XGEN(b.x)], 1u);
            asm volatile("s_waitcnt vmcnt(0)" ::: "memory");
        } else {
            XB_SPIN(xb_ld(&bar[XB_XGEN(b.x)]) == gen, bar);
            __builtin_amdgcn_fence(__ATOMIC_ACQUIRE, "agent");
            asm volatile("s_waitcnt vmcnt(0)" ::: "memory");
        }
    }
    __syncthreads();
}
__device__ __forceinline__ float wave_sum(float v) {
#pragma unroll
    for (int o = 1; o < 64; o <<= 1) v += __shfl_xor(v, o);
    return v;
}

typedef unsigned short u16;
typedef float f32x2_t __attribute__((ext_vector_type(2)));
constexpr int NWAVES = 8;
constexpr int DM = 4096, T0 = 8192, T1 = 16384, M = T0 + T1;
constexpr int HGW = 2048, AW = 2048, KVW = 512, INW = 21504, DFF = 11008;
constexpr float EPS = 1e-6f;
constexpr size_t MiB = 1u << 20;
constexpr size_t WS_CTL = 0, CTL_ZERO_BYTES = 65536;
constexpr size_t WS_WA = 1 * MiB, WS_WB = 17 * MiB, WS_WOUT = 33 * MiB, WS_WGU = 65 * MiB, WS_WDN = 237 * MiB;
constexpr size_t WS_HQ = 323 * MiB, WS_ZF = 419 * MiB, WS_ZB = 515 * MiB, WS_HI = 611 * MiB, WS_HOG = 707 * MiB, WS_AQ = 803 * MiB;
constexpr size_t WS_AK = 899 * MiB, WS_AV = 923 * MiB, WS_GA = 947 * MiB, WS_GB = 1139 * MiB, WS_END = 1331 * MiB;
constexpr size_t WS_T = WS_ZF, WS_MERGED = WS_HI, WS_XN2 = WS_GA, WS_ACT = WS_HQ, WS_X1B = WS_GB, WS_X2B = WS_GA;
constexpr size_t DO_WIN = 0, DO_H = 168 * MiB, DO_OF = 0, DO_OB = 192 * MiB;
static_assert(WS_ACT + (size_t)M * DFF * 2 <= WS_AK && DO_H + (size_t)M * DM * 2 <= (size_t)M * DM * 4, "maps");
constexpr int CW_BAR = 4096;
constexpr int LDS_BYTES = 147456;
constexpr int MISC_OFF = 131072 + 320;

typedef _Float16 f16x2_t __attribute__((ext_vector_type(2)));
typedef _Float16 f16x8_t __attribute__((ext_vector_type(8)));
typedef unsigned u32x2_t __attribute__((ext_vector_type(2)));
typedef __bf16 bf16x2_t __attribute__((ext_vector_type(2)));
__device__ __forceinline__ unsigned pkbf(float lo, float hi) { f32x2_t v = {lo, hi}; bf16x2_t b = __builtin_convertvector(v, bf16x2_t); return __builtin_bit_cast(unsigned, b); }
__device__ __forceinline__ unsigned pkh(float lo, float hi) { f32x2_t v = {lo, hi}; f16x2_t h = __builtin_convertvector(v, f16x2_t); return __builtin_bit_cast(unsigned, h); }
__device__ __forceinline__ float bflo(unsigned w) { return __uint_as_float(w << 16); }
__device__ __forceinline__ float bfhi(unsigned w) { return __uint_as_float(w & 0xffff0000u); }
__device__ __forceinline__ float bf1(u16 h) { return __uint_as_float(((unsigned)h) << 16); }
__device__ __forceinline__ float sigm(float x) { return __builtin_amdgcn_rcpf(1.0f + __expf(-x)); }

template <int OP>
__device__ __forceinline__ void epi_store16(const pg8::f32x4 (&acc)[2][2][4][2], u16* base, int ldc, int row0, int col0) {
#pragma unroll
    for (int ai = 0; ai < 2; ++ai)
#pragma unroll
        for (int m = 0; m < 4; ++m) { u16* rowp = base + (size_t)(row0 + ai * 128 + m * 16) * ldc + col0;
#pragma unroll
            for (int bj = 0; bj < 2; ++bj) { pg8::f32x4 v0 = acc[ai][bj][m][0], v1 = acc[ai][bj][m][1];
                if (OP == 2) {
#pragma unroll
                    for (int e = 0; e < 4; ++e) { v0[e] = v0[e] * sigm(v0[e]); v1[e] = v1[e] * sigm(v1[e]); } }
                if (OP == 3) {
#pragma unroll
                    for (int e = 0; e < 4; ++e) { v0[e] = sigm(v0[e]); v1[e] = sigm(v1[e]); } }
                pg8::u32x4 w;
                if (OP == 1) { w.x = pkh(v0[0], v0[1]); w.y = pkh(v0[2], v0[3]); w.z = pkh(v1[0], v1[1]); w.w = pkh(v1[2], v1[3]); }
                else { w.x = pkbf(v0[0], v0[1]); w.y = pkbf(v0[2], v0[3]); w.z = pkbf(v1[0], v1[1]); w.w = pkbf(v1[2], v1[3]); }
                *(pg8::u32x4*)(rowp + bj * 128) = w; } }
}
struct EpiInProj {
    static constexpr bool PERM = true, AFTER_DRAIN = false;
    unsigned char* ws;
    __device__ __forceinline__ void operator()(const pg8::f32x4 (&acc)[2][2][4][2], const pg8::Unit& u, int wr, int wc, int fr, int fq) const {
        const int pn = u.pn, row0 = u.pm * 256 + wr * 64 + fr, cw = wc * 32 + 8 * fq;
        if (pn < 8)       epi_store16<0>(acc, (u16*)(ws + WS_HQ), HGW, row0, (pn - 0) * 256 + cw);
        else if (pn < 16) epi_store16<1>(acc, (u16*)(ws + WS_ZF), HGW, row0, (pn - 8) * 256 + cw);
        else if (pn < 24) epi_store16<1>(acc, (u16*)(ws + WS_ZB), HGW, row0, (pn - 16) * 256 + cw);
        else if (pn < 32) epi_store16<0>(acc, (u16*)(ws + WS_HI), HGW, row0, (pn - 24) * 256 + cw);
        else if (pn < 40) epi_store16<2>(acc, (u16*)(ws + WS_HOG), HGW, row0, (pn - 32) * 256 + cw);
        else if (pn < 48) epi_store16<0>(acc, (u16*)(ws + WS_AQ), AW, row0, (pn - 40) * 256 + cw);
        else if (pn < 50) epi_store16<0>(acc, (u16*)(ws + WS_AK), KVW, row0, (pn - 48) * 256 + cw);
        else if (pn < 52) epi_store16<0>(acc, (u16*)(ws + WS_AV), KVW, row0, (pn - 50) * 256 + cw);
        else if (pn < 68) epi_store16<3>(acc, (u16*)(ws + WS_GA), DM, row0, (pn - 52) * 256 + cw);
        else              epi_store16<3>(acc, (u16*)(ws + WS_GB), DM, row0, (pn - 68) * 256 + cw);
    }
};
template <bool ADD> struct EpiGate {
    static constexpr bool PERM = true, AFTER_DRAIN = false;
    const u16* sg; const u16* tin; u16* out;
    __device__ __forceinline__ void operator()(const pg8::f32x4 (&acc)[2][2][4][2], const pg8::Unit& u, int wr, int wc, int fr, int fq) const {
        const int row0 = u.pm * 256 + wr * 64 + fr, col0 = u.pn * 256 + wc * 32 + 8 * fq;
#pragma unroll
        for (int ai = 0; ai < 2; ++ai)
#pragma unroll
            for (int mp = 0; mp < 2; ++mp) {
                pg8::u32x4 g[2][2], t[2][2];
#pragma unroll
                for (int mm = 0; mm < 2; ++mm)
#pragma unroll
                    for (int bj = 0; bj < 2; ++bj) { const size_t off = (size_t)(row0 + ai * 128 + (2 * mp + mm) * 16) * DM + col0 + bj * 128;
                        g[mm][bj] = *(const pg8::u32x4*)(sg + off); if (ADD) t[mm][bj] = *(const pg8::u32x4*)(tin + off); }
                __builtin_amdgcn_sched_barrier(0);
#pragma unroll
                for (int mm = 0; mm < 2; ++mm)
#pragma unroll
                    for (int bj = 0; bj < 2; ++bj) { const int m = 2 * mp + mm; const size_t off = (size_t)(row0 + ai * 128 + m * 16) * DM + col0 + bj * 128;
                        const pg8::f32x4 v0 = acc[ai][bj][m][0], v1 = acc[ai][bj][m][1]; const pg8::u32x4 gg = g[mm][bj];
                        float r[8] = {bflo(gg.x) * v0[0], bfhi(gg.x) * v0[1], bflo(gg.y) * v0[2], bfhi(gg.y) * v0[3], bflo(gg.z) * v1[0], bfhi(gg.z) * v1[1], bflo(gg.w) * v1[2], bfhi(gg.w) * v1[3]};
                        if (ADD) { const pg8::u32x4 tt = t[mm][bj];
                            r[0] += bflo(tt.x); r[1] += bfhi(tt.x); r[2] += bflo(tt.y); r[3] += bfhi(tt.y); r[4] += bflo(tt.z); r[5] += bfhi(tt.z); r[6] += bflo(tt.w); r[7] += bfhi(tt.w); }
                        pg8::u32x4 w; w.x = pkbf(r[0], r[1]); w.y = pkbf(r[2], r[3]); w.z = pkbf(r[4], r[5]); w.w = pkbf(r[6], r[7]);
                        *(pg8::u32x4*)(out + off) = w; }
                __builtin_amdgcn_sched_barrier(0);
            }
    }
};
struct EpiResF32 {
    static constexpr bool PERM = true, AFTER_DRAIN = false;
    const float* base0; const float* base1; float* out;
    __device__ __forceinline__ void operator()(const pg8::f32x4 (&acc)[2][2][4][2], const pg8::Unit& u, int wr, int wc, int fr, int fq) const {
        const int col0 = u.pn * 256 + wc * 32 + 8 * fq;
        const int r0t = u.pm * 256;
        const float* bt = (r0t < T0) ? base0 + (size_t)r0t * DM : base1 + (size_t)(r0t - T0) * DM; float* ot = out + (size_t)r0t * DM;
#pragma unroll
        for (int ai = 0; ai < 2; ++ai)
#pragma unroll
            for (int mp = 0; mp < 2; ++mp) {
                pg8::f32x4 b[2][2][2];
#pragma unroll
                for (int mm = 0; mm < 2; ++mm)
#pragma unroll
                    for (int bj = 0; bj < 2; ++bj) { const float* bs = bt + (size_t)(ai * 128 + wr * 64 + (2 * mp + mm) * 16 + fr) * DM + col0 + bj * 128;
                        b[mm][bj][0] = *(const pg8::f32x4*)bs; b[mm][bj][1] = *(const pg8::f32x4*)(bs + 4); }
                __builtin_amdgcn_sched_barrier(0);
#pragma unroll
                for (int mm = 0; mm < 2; ++mm)
#pragma unroll
                    for (int bj = 0; bj < 2; ++bj) { const int m = 2 * mp + mm; float* op = ot + (size_t)(ai * 128 + wr * 64 + m * 16 + fr) * DM + col0 + bj * 128;
                        *(pg8::f32x4*)op = b[mm][bj][0] + acc[ai][bj][m][0]; *(pg8::f32x4*)(op + 4) = b[mm][bj][1] + acc[ai][bj][m][1]; }
                __builtin_amdgcn_sched_barrier(0);
            }
    }
};
struct EpiResToB16 {
    static constexpr bool PERM = true, AFTER_DRAIN = false;
    const float* base0; const float* base1; u16* out;
    __device__ __forceinline__ void operator()(const pg8::f32x4 (&acc)[2][2][4][2], const pg8::Unit& u, int wr, int wc, int fr, int fq) const {
        const int col0 = u.pn * 256 + wc * 32 + 8 * fq;
        const int r0t = u.pm * 256;
        const float* bt = (r0t < T0) ? base0 + (size_t)r0t * DM : base1 + (size_t)(r0t - T0) * DM; u16* ot = out + (size_t)r0t * DM;
#pragma unroll
        for (int ai = 0; ai < 2; ++ai)
#pragma unroll
            for (int mp = 0; mp < 2; ++mp) {
                pg8::f32x4 b[2][2][2];
#pragma unroll
                for (int mm = 0; mm < 2; ++mm)
#pragma unroll
                    for (int bj = 0; bj < 2; ++bj) { const float* bs = bt + (size_t)(ai * 128 + wr * 64 + (2 * mp + mm) * 16 + fr) * DM + col0 + bj * 128;
                        b[mm][bj][0] = *(const pg8::f32x4*)bs; b[mm][bj][1] = *(const pg8::f32x4*)(bs + 4); }
                __builtin_amdgcn_sched_barrier(0);
#pragma unroll
                for (int mm = 0; mm < 2; ++mm)
#pragma unroll
                    for (int bj = 0; bj < 2; ++bj) { const int m = 2 * mp + mm; u16* op = ot + (size_t)(ai * 128 + wr * 64 + m * 16 + fr) * DM + col0 + bj * 128;
                        const pg8::f32x4 v0 = b[mm][bj][0] + acc[ai][bj][m][0], v1 = b[mm][bj][1] + acc[ai][bj][m][1];
                        pg8::u32x4 w; w.x = pkbf(v0[0], v0[1]); w.y = pkbf(v0[2], v0[3]); w.z = pkbf(v1[0], v1[1]); w.w = pkbf(v1[2], v1[3]);
                        *(pg8::u32x4*)op = w; }
                __builtin_amdgcn_sched_barrier(0);
            }
    }
};
struct EpiResFromB16 {
    static constexpr bool PERM = true, AFTER_DRAIN = false;
    const u16* res; float* out;
    __device__ __forceinline__ void operator()(const pg8::f32x4 (&acc)[2][2][4][2], const pg8::Unit& u, int wr, int wc, int fr, int fq) const {
        const size_t o0 = (size_t)(u.pm * 256 + wr * 64 + fr) * DM + u.pn * 256 + wc * 32 + 8 * fq;
#pragma unroll
        for (int ai = 0; ai < 2; ++ai) {
            pg8::u32x4 b[4][2];
#pragma unroll
            for (int m = 0; m < 4; ++m)
#pragma unroll
                for (int bj = 0; bj < 2; ++bj) b[m][bj] = *(const pg8::u32x4*)(res + o0 + (size_t)(ai * 128 + m * 16) * DM + bj * 128);
            __builtin_amdgcn_sched_barrier(0);
#pragma unroll
            for (int m = 0; m < 4; ++m)
#pragma unroll
                for (int bj = 0; bj < 2; ++bj) { float* op = out + o0 + (size_t)(ai * 128 + m * 16) * DM + bj * 128; const pg8::u32x4 g = b[m][bj];
                    const pg8::f32x4 r0 = {bflo(g.x), bfhi(g.x), bflo(g.y), bfhi(g.y)}, r1 = {bflo(g.z), bfhi(g.z), bflo(g.w), bfhi(g.w)};
                    *(pg8::f32x4*)op = r0 + acc[ai][bj][m][0]; *(pg8::f32x4*)(op + 4) = r1 + acc[ai][bj][m][1]; }
            __builtin_amdgcn_sched_barrier(0);
        }
    }
};
struct EpiPlainB16 {
    static constexpr bool PERM = true, AFTER_DRAIN = false;
    u16* out;
    __device__ __forceinline__ void operator()(const pg8::f32x4 (&acc)[2][2][4][2], const pg8::Unit& u, int wr, int wc, int fr, int fq) const {
        epi_store16<0>(acc, out, DM, u.pm * 256 + wr * 64 + fr, u.pn * 256 + wc * 32 + 8 * fq);
    }
};
struct EpiResB16 {
    static constexpr bool PERM = true, AFTER_DRAIN = false;
    const u16* res; u16* out;
    __device__ __forceinline__ void operator()(const pg8::f32x4 (&acc)[2][2][4][2], const pg8::Unit& u, int wr, int wc, int fr, int fq) const {
        const size_t o0 = (size_t)(u.pm * 256 + wr * 64 + fr) * DM + u.pn * 256 + wc * 32 + 8 * fq;
#pragma unroll
        for (int ai = 0; ai < 2; ++ai) {
            pg8::u32x4 b[4][2];
#pragma unroll
            for (int m = 0; m < 4; ++m)
#pragma unroll
                for (int bj = 0; bj < 2; ++bj) b[m][bj] = *(const pg8::u32x4*)(res + o0 + (size_t)(ai * 128 + m * 16) * DM + bj * 128);
            __builtin_amdgcn_sched_barrier(0);
#pragma unroll
            for (int m = 0; m < 4; ++m)
#pragma unroll
                for (int bj = 0; bj < 2; ++bj) { const pg8::u32x4 g = b[m][bj]; const pg8::f32x4 v0 = acc[ai][bj][m][0], v1 = acc[ai][bj][m][1];
                    pg8::u32x4 w; w.x = pkbf(bflo(g.x) + v0[0], bfhi(g.x) + v0[1]); w.y = pkbf(bflo(g.y) + v0[2], bfhi(g.y) + v0[3]); w.z = pkbf(bflo(g.z) + v1[0], bfhi(g.z) + v1[1]); w.w = pkbf(bflo(g.w) + v1[2], bfhi(g.w) + v1[3]);
                    *(pg8::u32x4*)(out + o0 + (size_t)(ai * 128 + m * 16) * DM + bj * 128) = w; }
            __builtin_amdgcn_sched_barrier(0);
        }
    }
};
struct EpiSwiGLU {
    static constexpr bool PERM = true, AFTER_DRAIN = false;
    u16* out;
    __device__ __forceinline__ void operator()(const pg8::f32x4 (&acc)[2][2][4][2], const pg8::Unit& u, int wr, int wc, int fr, int fq) const {
        const int row0 = u.pm * 256 + wr * 64 + fr, col0 = u.pn * 128 + wc * 32 + 8 * fq;
#pragma unroll
        for (int ai = 0; ai < 2; ++ai)
#pragma unroll
            for (int m = 0; m < 4; ++m) { const pg8::f32x4 g0 = acc[ai][0][m][0], g1 = acc[ai][0][m][1], u0 = acc[ai][1][m][0], u1 = acc[ai][1][m][1];
                float r[8];
#pragma unroll
                for (int e = 0; e < 4; ++e) { r[e] = g0[e] * sigm(g0[e]) * u0[e]; r[4 + e] = g1[e] * sigm(g1[e]) * u1[e]; }
                pg8::u32x4 w; w.x = pkbf(r[0], r[1]); w.y = pkbf(r[2], r[3]); w.z = pkbf(r[4], r[5]); w.w = pkbf(r[6], r[7]);
                *(pg8::u32x4*)(out + (size_t)(row0 + ai * 128 + m * 16) * DFF + col0) = w; }
    }
};


namespace att {
using bf16x8 = __attribute__((ext_vector_type(8))) short;
using s16x4  = __attribute__((ext_vector_type(4))) short;
using f32x16 = __attribute__((ext_vector_type(16))) float;
using u32x4  = __attribute__((ext_vector_type(4))) unsigned;
using f32x4  = __attribute__((ext_vector_type(4))) float;
constexpr int   D = 128, NW = 8, QBLK = 32, KVBLK = 64, LDQ = 2048, LDK = 512;
constexpr float SCALE = 0.088388347648318440f;
constexpr size_t SHM_V = KVBLK * D * 2, SHM_K = KVBLK * D * 2, RING = 4, WS_OFF = 132096;
#define KSWZ(row, colB) ((row) * 256 + ((colB) ^ (((row) & 15) << 4)))
#define SBAR() __builtin_amdgcn_sched_barrier(0)
__device__ __forceinline__ int crow(int r, int hi) { return (r & 3) + 8 * (r >> 2) + 4 * hi; }
__device__ __forceinline__ unsigned cvtpk(float lo, float hi) { return pkbf(lo, hi); }
template <bool SHIFT> __device__ __forceinline__ void partialSM(f32x16& p0, f32x16& p1, float negBl2) {
  constexpr float C = SCALE * 1.4426950408889634f;
  if constexpr (SHIFT) {
    for (int r = 0; r < 16; ++r) { float t = fmaf(p0[r], C, negBl2); asm("" : "+v"(t)); p0[r] = t; } for (int r = 0; r < 16; ++r) { float t = fmaf(p1[r], C, negBl2); asm("" : "+v"(t)); p1[r] = t; } }
  for (int r = 0; r < 16; ++r) p0[r] = __builtin_amdgcn_exp2f(p0[r]);
}
__device__ __forceinline__ void qkt(f32x16& p0, f32x16& p1, const u16* Ks, const bf16x8* qr, int r32, int hi) {
  p0 = f32x16{}; p1 = f32x16{};
  const char* k0p = (const char*)Ks + r32 * 256; const char* k1p = k0p + 32 * 256; const int sw = (r32 & 15) << 4, hb = hi * 16;
#define QK_RD(d0, A, B) do { const int cb_ = ((d0) * 32 + hb) ^ sw; A = *reinterpret_cast<const bf16x8*>(k0p + cb_); B = *reinterpret_cast<const bf16x8*>(k1p + cb_); } while (0)
  bf16x8 a0, b0, a1, b1, c0, d0_, c1, d1;
  QK_RD(0, a0, b0); QK_RD(1, a1, b1);
#pragma unroll
  for (int g = 0; g < 4; ++g) {
    if (g < 3) { QK_RD(2 * g + 2, c0, d0_); QK_RD(2 * g + 3, c1, d1); }
    SBAR();
    p0 = __builtin_amdgcn_mfma_f32_32x32x16_bf16(a0, qr[2 * g], p0, 0, 0, 0); p1 = __builtin_amdgcn_mfma_f32_32x32x16_bf16(b0, qr[2 * g], p1, 0, 0, 0);
    p0 = __builtin_amdgcn_mfma_f32_32x32x16_bf16(a1, qr[2 * g + 1], p0, 0, 0, 0); p1 = __builtin_amdgcn_mfma_f32_32x32x16_bf16(b1, qr[2 * g + 1], p1, 0, 0, 0);
    SBAR();
    a0 = c0; b0 = d0_; a1 = c1; b1 = d1;
  }
#undef QK_RD
}
__device__ __forceinline__ int v_st(int k, int c) { const int kk = (k & ~0xC) | ((k & 4) << 1) | ((k & 8) >> 1); return ((kk >> 3) * 4 + (c >> 5)) * 512 + ((kk & 7) * 32 + (c & 31)) * 2; }
__device__ __forceinline__ int v_rd_base(int lane) { return ((lane & 3) << 3) | (((lane >> 2) & 3) << 6) | (((lane >> 4) & 1) << 5) | (((lane >> 5) & 1) << 8); }
constexpr int v_rd_off(int d0, int ks, int half) { return d0 * 512 + ks * 4096 + half * 2048; }
template <int OFF> __device__ __forceinline__ s16x4 tr_read(int vb) {
  s16x4 r; asm volatile("ds_read_b64_tr_b16 %0, %1 offset:%2" : "=&v"(r) : "v"(vb), "i"(OFF) : "memory"); return r;
}
template <int D0> __device__ __forceinline__ void pv_one(f32x16& od, int vb, bf16x8 pa0, bf16x8 pa1, bf16x8 pa2, bf16x8 pa3) {
  const s16x4 l0 = tr_read<v_rd_off(D0, 0, 0)>(vb), h0 = tr_read<v_rd_off(D0, 0, 1)>(vb), l1 = tr_read<v_rd_off(D0, 1, 0)>(vb), h1 = tr_read<v_rd_off(D0, 1, 1)>(vb);
  const s16x4 l2 = tr_read<v_rd_off(D0, 2, 0)>(vb), h2 = tr_read<v_rd_off(D0, 2, 1)>(vb), l3 = tr_read<v_rd_off(D0, 3, 0)>(vb), h3 = tr_read<v_rd_off(D0, 3, 1)>(vb);
  asm volatile("s_waitcnt lgkmcnt(0)" ::: "memory"); SBAR();
#define PK(L, H) (bf16x8){L[0], L[1], L[2], L[3], H[0], H[1], H[2], H[3]}
  od = __builtin_amdgcn_mfma_f32_32x32x16_bf16(pa0, PK(l0, h0), od, 0, 0, 0);
  od = __builtin_amdgcn_mfma_f32_32x32x16_bf16(pa1, PK(l1, h1), od, 0, 0, 0);
  od = __builtin_amdgcn_mfma_f32_32x32x16_bf16(pa2, PK(l2, h2), od, 0, 0, 0);
  od = __builtin_amdgcn_mfma_f32_32x32x16_bf16(pa3, PK(l3, h3), od, 0, 0, 0);
#undef PK
}
__device__ __forceinline__ void pv_d0(f32x16* o, int vb, bf16x8 pa0, bf16x8 pa1, bf16x8 pa2, bf16x8 pa3) {
  pv_one<0>(o[0], vb, pa0, pa1, pa2, pa3); pv_one<1>(o[1], vb, pa0, pa1, pa2, pa3); pv_one<2>(o[2], vb, pa0, pa1, pa2, pa3); pv_one<3>(o[3], vb, pa0, pa1, pa2, pa3);
}
#define PIN(x) asm volatile("" : "+v"(x))
#define MF32(a, b, c) __builtin_amdgcn_mfma_f32_32x32x16_bf16(a, b, c, 0, 0, 0)
struct VFrag { s16x4 l0, h0, l1, h1, l2, h2, l3, h3; };
#define VF_RD2(F, D0, KS, vb) do { F.l##KS = tr_read<v_rd_off(D0, KS, 0)>(vb); F.h##KS = tr_read<v_rd_off(D0, KS, 1)>(vb); } while (0)
#define VF_PK(F, KS) (bf16x8){F.l##KS[0], F.l##KS[1], F.l##KS[2], F.l##KS[3], F.h##KS[0], F.h##KS[1], F.h##KS[2], F.h##KS[3]}
#define PK4F(P, BASE, OUT) do { u32x4 w_ = {cvtpk(P[BASE + 0], P[BASE + 1]), cvtpk(P[BASE + 2], P[BASE + 3]), cvtpk(P[BASE + 4], P[BASE + 5]), cvtpk(P[BASE + 6], P[BASE + 7])}; \
    OUT = *reinterpret_cast<bf16x8*>(&w_); } while (0)
#define VF_RDF(F, D0, KS, vb) do { F.l##D0 = tr_read<v_rd_off(D0, KS, 0)>(vb); F.h##D0 = tr_read<v_rd_off(D0, KS, 1)>(vb); } while (0)
#define VF_PKF(F, D0) (bf16x8){F.l##D0[0], F.l##D0[1], F.l##D0[2], F.l##D0[3], F.h##D0[0], F.h##D0[1], F.h##D0[2], F.h##D0[3]}
#define BC8(w) __builtin_bit_cast(bf16x8, w)
template <int OFF> __device__ __forceinline__ bf16x8 kread(int a) { bf16x8 r; asm volatile("ds_read_b128 %0, %1 offset:%2" : "=&v"(r) : "v"(a), "i"(OFF) : "memory"); return r; }
__device__ __forceinline__ void stepA(f32x16& n0, f32x16& n1, const u16* Ks, const bf16x8* qr, int r32, int hi, f32x16& p0, f32x16& p1, float& lA,
                                      u32x4& w0, u32x4& w1, u32x4& w2, VFrag& vf, int vb) {
  const int swb = ((r32 & 15) << 4) ^ (hi * 16), kl = (int)(uintptr_t)Ks + r32 * 256;
  int kbm[8];
#pragma unroll
  for (int d = 0; d < 8; ++d) kbm[d] = kl + (swb ^ (d * 32));
#define KR(X, d0, B) X = kread<(B) * 8192>(kbm[d0])
#define GA(i, WN, MF, RD, CV) do { asm volatile("s_waitcnt lgkmcnt(" #WN ")" ::: "memory"); SBAR(); MF; RD; { float e_ = __builtin_amdgcn_exp2f(p1[i]); PIN(e_); p1[i] = e_; } \
    lA += ((i) == 0 ? p0[15] : p1[(i) == 0 ? 0 : (i) - 1]); CV; PIN(lA); SBAR(); } while (0)
  bf16x8 x0, x1, x2, x3, y0, y1, y2, y3;
  KR(x0, 0, 0); KR(x1, 0, 1); KR(x2, 1, 0); KR(x3, 1, 1); SBAR();
  GA(0,  3, n0 = MF32(x0, qr[0], f32x16{}), KR(y0, 2, 0), { w0[0] = cvtpk(p0[0], p0[1]);   PIN(w0); });
  GA(1,  3, n1 = MF32(x1, qr[0], f32x16{}), KR(y1, 2, 1), { w0[1] = cvtpk(p0[2], p0[3]);   PIN(w0); });
  GA(2,  3, n0 = MF32(x2, qr[1], n0),       KR(y2, 3, 0), { w0[2] = cvtpk(p0[4], p0[5]);   PIN(w0); });
  GA(3,  3, n1 = MF32(x3, qr[1], n1),       KR(y3, 3, 1), { w0[3] = cvtpk(p0[6], p0[7]);   PIN(w0); });
  GA(4,  3, n0 = MF32(y0, qr[2], n0),       KR(x0, 4, 0), { w1[0] = cvtpk(p0[8], p0[9]);   PIN(w1); });
  GA(5,  3, n1 = MF32(y1, qr[2], n1),       KR(x1, 4, 1), { w1[1] = cvtpk(p0[10], p0[11]); PIN(w1); });
  GA(6,  3, n0 = MF32(y2, qr[3], n0),       KR(x2, 5, 0), { w1[2] = cvtpk(p0[12], p0[13]); PIN(w1); });
  GA(7,  3, n1 = MF32(y3, qr[3], n1),       KR(x3, 5, 1), { w1[3] = cvtpk(p0[14], p0[15]); PIN(w1); });
  GA(8,  3, n0 = MF32(x0, qr[4], n0),       KR(y0, 6, 0), { w2[0] = cvtpk(p1[0], p1[1]);   PIN(w2); });
  GA(9,  3, n1 = MF32(x1, qr[4], n1),       KR(y1, 6, 1), { w2[1] = cvtpk(p1[2], p1[3]);   PIN(w2); });
  GA(10, 3, n0 = MF32(x2, qr[5], n0),       KR(y2, 7, 0), { w2[2] = cvtpk(p1[4], p1[5]);   PIN(w2); });
  GA(11, 3, n1 = MF32(x3, qr[5], n1),       KR(y3, 7, 1), { w2[3] = cvtpk(p1[6], p1[7]);   PIN(w2); });
  GA(12, 3, n0 = MF32(y0, qr[6], n0),       VF_RDF(vf, 0, 0, vb), {});
  GA(13, 4, n1 = MF32(y1, qr[6], n1),       VF_RDF(vf, 1, 0, vb), {});
  GA(14, 5, n0 = MF32(y2, qr[7], n0),       VF_RDF(vf, 2, 0, vb), {});
  GA(15, 6, n1 = MF32(y3, qr[7], n1),       VF_RDF(vf, 3, 0, vb), {});
#undef KR
#undef GA
}
struct DmaCtx { const u16* Kh; const u16* Vh; int kgo0, kgo1, vgo0, vgo1; LAS unsigned char* ldsa; int wid, s, NT; };
#define DMAP(base, t, go, ring_off, img, i) __builtin_amdgcn_global_load_lds((const unsigned*)((base) + (size_t)(t) * (KVBLK * LDK) + (go)), \
    (LAS unsigned*)(dc.ldsa + (ring_off) + ((t) & 3) * (img) + dc.wid * 1024 + (i) * 8192), 16, 0, 0)
template <bool SHIFT, bool DMA> __device__ __forceinline__ void stepB(f32x16* o, int vb, u32x4 w0, u32x4 w1, u32x4 w2, f32x16& p1, VFrag& vf, f32x16& n0, f32x16& n1, float& lA, float& lB, float negBl2, const DmaCtx& dc) {
  const int tk3 = (dc.s + 3 < dc.NT) ? dc.s + 3 : dc.NT - 1;
  constexpr float C = SCALE * 1.4426950408889634f;
  VFrag vg; u32x4 w3;
#define FB(j) do { if constexpr (SHIFT) { float t0_ = fmaf(n0[j], C, negBl2), t1_ = fmaf(n1[j], C, negBl2); PIN(t0_); PIN(t1_); n0[j] = t0_; n1[j] = t1_; \
      if ((j) > 0) { float e_ = __builtin_amdgcn_exp2f(n0[(j) > 0 ? (j) - 1 : 0]); PIN(e_); n0[(j) > 0 ? (j) - 1 : 0] = e_; } if ((j) > 1) lB += n0[(j) > 1 ? (j) - 2 : 0]; } \
    else { float e_ = __builtin_amdgcn_exp2f(n0[j]); PIN(e_); n0[j] = e_; if ((j) > 0) lB += n0[(j) > 0 ? (j) - 1 : 0]; } PIN(lB); } while (0)
#define GB(j, WN, W, F, D0, RD, EXTRA) do { asm volatile("s_waitcnt lgkmcnt(" #WN ")" ::: "memory"); SBAR(); o[D0] = MF32(BC8(W), VF_PKF(F, D0), o[D0]); RD; FB(j); EXTRA; SBAR(); } while (0)
  GB(0,  6,w0, vf, 0, VF_RDF(vg, 0, 1, vb), { w3[0] = cvtpk(p1[8], p1[9]);   lA += p1[15]; PIN(w3); PIN(lA); });
  GB(1,  6,w0, vf, 1, VF_RDF(vg, 1, 1, vb), { w3[1] = cvtpk(p1[10], p1[11]); PIN(w3); });
  GB(2,  6,w0, vf, 2, VF_RDF(vg, 2, 1, vb), { w3[2] = cvtpk(p1[12], p1[13]); PIN(w3); });
  GB(3,  6,w0, vf, 3, VF_RDF(vg, 3, 1, vb), { w3[3] = cvtpk(p1[14], p1[15]); PIN(w3); });
  GB(4,  6,w1, vg, 0, VF_RDF(vf, 0, 2, vb), {});
  GB(5,  6,w1, vg, 1, VF_RDF(vf, 1, 2, vb), {});
  GB(6,  6,w1, vg, 2, VF_RDF(vf, 2, 2, vb), {});
  GB(7,  6,w1, vg, 3, VF_RDF(vf, 3, 2, vb), {});
  GB(8,  6,w2, vf, 0, VF_RDF(vg, 0, 3, vb), { if constexpr (DMA) DMAP(dc.Kh, dc.s + 2, dc.kgo0, RING * SHM_V, SHM_K, 0); });
  GB(9,  6,w2, vf, 1, VF_RDF(vg, 1, 3, vb), { if constexpr (DMA) DMAP(dc.Kh, dc.s + 2, dc.kgo1, RING * SHM_V, SHM_K, 1); });
  GB(10, 6,w2, vf, 2, VF_RDF(vg, 2, 3, vb), { if constexpr (DMA) DMAP(dc.Vh, dc.s + 1, dc.vgo0, 0, SHM_V, 0); });
  GB(11, 6,w2, vf, 3, VF_RDF(vg, 3, 3, vb), { if constexpr (DMA) DMAP(dc.Vh, dc.s + 1, dc.vgo1, 0, SHM_V, 1); });
  GB(12, 6,w3, vg, 0, {}, { if constexpr (DMA) DMAP(dc.Kh, tk3, dc.kgo0, RING * SHM_V, SHM_K, 0); });
  GB(13, 4,w3, vg, 1, {}, { if constexpr (DMA) DMAP(dc.Kh, tk3, dc.kgo1, RING * SHM_V, SHM_K, 1); });
  GB(14, 2,w3, vg, 2, {}, { if constexpr (DMA) DMAP(dc.Vh, dc.s + 2, dc.vgo0, 0, SHM_V, 0); });
  GB(15, 0,w3, vg, 3, {}, { if constexpr (DMA) DMAP(dc.Vh, dc.s + 2, dc.vgo1, 0, SHM_V, 1); });
  if constexpr (SHIFT) { float e_ = __builtin_amdgcn_exp2f(n0[15]); PIN(e_); n0[15] = e_; lB += n0[14]; }
#undef FB
#undef GB
}
#undef DMAP
__device__ __forceinline__ void finish_last(f32x16& p0, f32x16& p1, float& l, bf16x8& pa0, bf16x8& pa1, bf16x8& pa2, bf16x8& pa3) {
  for (int r = 0; r < 16; ++r) p1[r] = __builtin_amdgcn_exp2f(p1[r]);
  float ps = p0[15]; for (int r = 0; r < 16; ++r) ps += p1[r];
  l += ps;
  PK4F(p0, 0, pa0); PK4F(p0, 8, pa1); PK4F(p1, 0, pa2); PK4F(p1, 8, pa3);
}
template <bool SHIFT> __device__ __forceinline__ void attn_unit(u16* Qb, const u16* __restrict__ Kh, const u16* __restrict__ Vh, const float* __restrict__ qnw, int pos0, int seq, float negBl2, char* lds) {
  int tid = threadIdx.x; asm volatile("" : "+v"(tid));
  const int wid = __builtin_amdgcn_readfirstlane(tid >> 6), lane = tid & 63, r32 = lane & 31, hi = lane >> 5;
  u16* V_lds = (u16*)lds; u16* K_lds = (u16*)(lds + RING * SHM_V);
  float* ws = (float*)(lds + WS_OFF) + wid * 64; float* li_l = ws;
  float l_reg = 0; f32x16 o[4] = {}; bf16x8 qr[8];
  int kgo[2], vgo[2];
#pragma unroll
  for (int i = 0; i < 2; ++i) { const int a = i * 8192 + tid * 16;
    { const int row = a >> 8, cb = (a & 255) ^ ((row & 15) << 4); kgo[i] = row * LDK + (cb >> 1); }
    { const int t = a >> 9, within = (a & 511) >> 1, kk = ((t >> 2) << 3) | (within >> 5), c = (t & 3) * 32 + (within & 31); vgo[i] = kk * LDK + c; } }
  LAS unsigned char* ldsa = (LAS unsigned char*)lds;
#define DMA_K(t) do { const u16* kt_ = Kh + (size_t)(t) * (KVBLK * LDK); LAS unsigned char* d_ = ldsa + RING * SHM_V + ((t) & 3) * SHM_K + wid * 1024; \
    __builtin_amdgcn_global_load_lds((const unsigned*)(kt_ + kgo[0]), (LAS unsigned*)d_, 16, 0, 0); __builtin_amdgcn_global_load_lds((const unsigned*)(kt_ + kgo[1]), (LAS unsigned*)(d_ + 8192), 16, 0, 0); } while (0)
#define DMA_V(t) do { const u16* vt_ = Vh + (size_t)(t) * (KVBLK * LDK); LAS unsigned char* d_ = ldsa + ((t) & 3) * SHM_V + wid * 1024; \
    __builtin_amdgcn_global_load_lds((const unsigned*)(vt_ + vgo[0]), (LAS unsigned*)d_, 16, 0, 0); __builtin_amdgcn_global_load_lds((const unsigned*)(vt_ + vgo[1]), (LAS unsigned*)(d_ + 8192), 16, 0, 0); } while (0)
#define LANDED() do { asm volatile("s_waitcnt vmcnt(0)" ::: "memory"); __syncthreads(); } while (0)
#define KSL(t) ((u16*)((char*)K_lds + ((t) & 3) * SHM_K))
#define VSL(t) (vb0 + ((t) & 3) * (int)SHM_V)
  DMA_K(0); DMA_V(0); DMA_K(1); DMA_K(2); DMA_V(1);
  {
    int hl = hi; asm volatile("" : "+v"(hl));
    const u16* Qw = Qb + (long)(wid * QBLK + r32) * LDQ + hi * 8;
    u32x4 raw[8];
#pragma unroll
    for (int d0 = 0; d0 < 8; ++d0) raw[d0] = *reinterpret_cast<const u32x4*>(Qw + d0 * 16);
    float ss = 0.f;
#pragma unroll
    for (int d0 = 0; d0 < 8; ++d0)
#pragma unroll
      for (int e = 0; e < 4; ++e) { const float a = bflo(raw[d0][e]), b = bfhi(raw[d0][e]); ss += a * a + b * b; }
    { auto rr = __builtin_amdgcn_permlane32_swap(__float_as_uint(ss), __float_as_uint(ss), false, false); ss = __uint_as_float(rr[0]) + __uint_as_float(rr[1]); }
    const float rstd = (SHIFT ? 1.0f : SCALE * 1.4426950408889634f) / sqrtf(ss * (1.0f / 128.0f) + EPS);
    const int pos = pos0 + wid * QBLK + r32; const float prow = (float)(pos >> 6), pcol = (float)(pos & 63);
#pragma unroll
    for (int d0 = 0; d0 < 8; ++d0) {
      const f32x4 w0 = *reinterpret_cast<const f32x4*>(qnw + d0 * 16 + hl * 8), w1 = *reinterpret_cast<const f32x4*>(qnw + d0 * 16 + hl * 8 + 4);
      const float wv[8] = {w0[0], w0[1], w0[2], w0[3], w1[0], w1[1], w1[2], w1[3]};
      u32x4 wq;
#pragma unroll
      for (int e = 0; e < 4; ++e) {
        const int fi = (d0 & 3) * 8 + hl * 4 + e;
        const float inv = exp2f(-(float)fi * 0.41524101186092029f);
        const float ang = (d0 < 4 ? prow : pcol) * inv; const float sn = __sinf(ang), cs = __cosf(ang);
        const float x0 = bflo(raw[d0][e]) * rstd * wv[2 * e], x1 = bfhi(raw[d0][e]) * rstd * wv[2 * e + 1];
        wq[e] = cvtpk(x0 * cs - x1 * sn, x0 * sn + x1 * cs); }
      qr[d0] = *reinterpret_cast<bf16x8*>(&wq); }
  }
  const int vb0 = (int)(uintptr_t)V_lds + v_rd_base(lane);
  f32x16 pA0, pA1, pB0, pB1; bf16x8 pa0, pa1, pa2, pa3; const int NT = seq / KVBLK;
  LANDED();
  qkt(pA0, pA1, KSL(0), qr, r32, hi); partialSM<SHIFT>(pA0, pA1, negBl2);
  float lA = 0.f, lB = 0.f; u32x4 w0, w1, w2;
#pragma unroll
  for (int r = 0; r < 15; ++r) lA += pA0[r];
  VFrag vf;
  DmaCtx dc{Kh, Vh, kgo[0], kgo[1], vgo[0], vgo[1], ldsa, wid, 0, NT};
  for (int s = 1; s + 1 < NT; s += 2) {
    LANDED();
    dc.s = s;
    SBAR(); stepA(pB0, pB1, KSL(s), qr, r32, hi, pA0, pA1, lA, w0, w1, w2, vf, VSL(s - 1)); SBAR();
    stepB<SHIFT, true>(o, VSL(s - 1), w0, w1, w2, pA1, vf, pB0, pB1, lA, lB, negBl2, dc);
    SBAR(); stepA(pA0, pA1, KSL(s + 1), qr, r32, hi, pB0, pB1, lA, w0, w1, w2, vf, VSL(s)); SBAR();
    stepB<SHIFT, false>(o, VSL(s), w0, w1, w2, pB1, vf, pA0, pA1, lA, lB, negBl2, dc);
  }
  LANDED();
  SBAR(); stepA(pB0, pB1, KSL(NT - 1), qr, r32, hi, pA0, pA1, lA, w0, w1, w2, vf, VSL(NT - 2)); SBAR();
  stepB<SHIFT, false>(o, VSL(NT - 2), w0, w1, w2, pA1, vf, pB0, pB1, lA, lB, negBl2, dc);
  l_reg = lA + lB;
  finish_last(pB0, pB1, l_reg, pa0, pa1, pa2, pa3); SBAR();
  pv_d0(o, VSL(NT - 1), pa0, pa1, pa2, pa3);
  { auto rr = __builtin_amdgcn_permlane32_swap(__float_as_uint(l_reg), __float_as_uint(l_reg), false, false); l_reg = __uint_as_float(rr[0]) + __uint_as_float(rr[1]); }
  if (hi == 0) li_l[r32] = l_reg; asm volatile("s_waitcnt lgkmcnt(0)" ::: "memory");
  float rli[16];
#pragma unroll
  for (int r = 0; r < 16; ++r) rli[r] = __builtin_amdgcn_rcpf(li_l[crow(r, hi)]);
  u16* Ow = Qb + (long)(wid * QBLK) * LDQ;
#pragma unroll
  for (int r = 0; r < 16; ++r) { const int oo = crow(r, hi) * LDQ + r32;
    for (int d0 = 0; d0 < 4; ++d0) Ow[oo + d0 * 32] = (u16)(cvtpk(o[d0][r] * rli[r], 0.f) & 0xffffu); }
  __syncthreads();
#undef DMA_K
#undef DMA_V
#undef LANDED
#undef KSL
#undef VSL
}
#undef PIN
#undef MF32
#undef VF_RD2
#undef VF_PK
#undef VF_RDF
#undef VF_PKF
#undef BC8
#undef PK4F
#undef KSWZ
#undef SBAR
}

namespace hg {
typedef short bf16x8 __attribute__((ext_vector_type(8)));
typedef float f32x4 __attribute__((ext_vector_type(4)));
typedef unsigned u32x4 __attribute__((ext_vector_type(4)));
constexpr int L_TOT = 0, L_VT = 8192, L_QT = 24576, L_QB = 40960, L_KT = 57344, L_P = 122880;
constexpr int L_RED = 0, L_RSTD = 2048, L_OUT = L_KT;
__device__ __forceinline__ int sidx(int gc, int h, int dir) { return (gc * 16 + h) * 2 + dir; }
__device__ __forceinline__ int off256(int row, int chunk) { return row * 256 + ((chunk ^ (row & 7)) << 4); }
__device__ __forceinline__ int off128(int row, int chunk) { return row * 128 + ((chunk ^ (row & 7)) << 4); }
__device__ __forceinline__ float h2f_lo(unsigned w) { f16x2_t h = __builtin_bit_cast(f16x2_t, w); return (float)h[0]; }
__device__ __forceinline__ float h2f_hi(unsigned w) { f16x2_t h = __builtin_bit_cast(f16x2_t, w); return (float)h[1]; }

__device__ __forceinline__ void gate_local(const unsigned (&zr)[8], const float* lbp, int cp, int tg, int dir, LAS unsigned char* lds, float (&kk)[8][2], float (&p)[8][2]) {
    float oml[2];
#pragma unroll
    for (int e = 0; e < 2; ++e) oml[e] = 1.0f - sigm(lbp[2 * cp + e] - lbp[HGW + 2 * cp + e]);
    float lf[8][2];
#pragma unroll
    for (int j = 0; j < 8; ++j)
#pragma unroll
        for (int e = 0; e < 2; ++e) { const float z = e ? h2f_hi(zr[j]) : h2f_lo(zr[j]); const float k1 = oml[e] * __builtin_amdgcn_rcpf(1.0f + __expf(z)); kk[j][e] = k1; lf[j][e] = __logf(1.0f - k1); }
#pragma unroll
    for (int e = 0; e < 2; ++e) { float run = 0.f;
        if (dir == 0) {
#pragma unroll
            for (int j = 0; j < 8; ++j) { run += lf[j][e]; p[j][e] = run; } }
        else {
#pragma unroll
            for (int j = 7; j >= 0; --j) { run += lf[j][e]; p[j][e] = run; } }
        ((LAS float*)(lds + L_TOT))[(dir * 8 + tg) * 128 + 2 * cp + e] = run; }
}
__device__ __forceinline__ void gate_global(int cp, int tg, int dir, LAS unsigned char* lds, float (&p)[8][2], float (&sub)[4][2], float (&R)[2], float (&Tot)[2]) {
    const LAS float* T = (const LAS float*)(lds + L_TOT) + dir * 8 * 128 + 2 * cp;
    float t8[8][2];
#pragma unroll
    for (int g = 0; g < 8; ++g) { const f32x2_t v = *(const LAS f32x2_t*)(T + g * 128); t8[g][0] = v.x; t8[g][1] = v.y; }
    const int I = tg >> 1; const bool second = dir ? ((tg & 1) == 0) : ((tg & 1) == 1);
#pragma unroll
    for (int e = 0; e < 2; ++e) {
#pragma unroll
        for (int i2 = 0; i2 < 4; ++i2) sub[i2][e] = t8[2 * i2][e] + t8[2 * i2 + 1][e];
        float partner = 0.f;
#pragma unroll
        for (int g = 0; g < 8; ++g) partner = (g == (tg ^ 1)) ? t8[g][e] : partner;
        const float add = second ? partner : 0.f;
#pragma unroll
        for (int j = 0; j < 8; ++j) p[j][e] += add;
        float r = 0.f;
#pragma unroll
        for (int i2 = 0; i2 < 4; ++i2) { const bool before = dir ? (i2 > I) : (i2 < I); r += before ? sub[i2][e] : 0.f; }
        R[e] = r; Tot[e] = (sub[0][e] + sub[1][e]) + (sub[2][e] + sub[3][e]); }
}

struct APre { unsigned zf[8], zb[8]; };
__device__ __forceinline__ void pass_a_load(APre& p, int gc, int h, const u16* ZF, const u16* ZB, int tid) {
    const int cp = tid & 63, tg = __builtin_amdgcn_readfirstlane(tid >> 6);
    const size_t row0 = (size_t)(gc >= 128 ? T0 + (gc - 128) * 64 : gc * 64);
    const size_t rowoff = (row0 + 8 * tg) * HGW + h * 128 + 2 * cp;
#pragma unroll
    for (int j = 0; j < 8; ++j) { p.zf[j] = *(const unsigned*)(ZF + rowoff + (size_t)j * HGW); p.zb[j] = *(const unsigned*)(ZB + rowoff + (size_t)j * HGW); }
}
__device__ __forceinline__ void pass_a_item(APre& pre, int ngc, int nh, bool has_next, int gc, int h, const u16* ZF, const u16* ZB, const u16* HI, const float* lbf, const float* lbb, u16* ST, float* DC, LAS unsigned char* lds, int tid) {
    const int cp = tid & 63, tg = __builtin_amdgcn_readfirstlane(tid >> 6), lane = tid & 63, fr = lane & 15, fq = lane >> 4, w = tg;
    const size_t row0 = (size_t)(gc >= 128 ? T0 + (gc - 128) * 64 : gc * 64);
    const size_t rowoff = (row0 + 8 * tg) * HGW + h * 128 + 2 * cp;
    unsigned vr[8];
#pragma unroll
    for (int j = 0; j < 8; ++j) vr[j] = *(const unsigned*)(HI + rowoff + (size_t)j * HGW);
    unsigned zf[8], zb[8];
#pragma unroll
    for (int j = 0; j < 8; ++j) { zf[j] = pre.zf[j]; zb[j] = pre.zb[j]; }
    float kk[2][8][2], p[2][8][2];
    gate_local(zf, lbf + h * 128, cp, tg, 0, lds, kk[0], p[0]);
    gate_local(zb, lbb + h * 128, cp, tg, 1, lds, kk[1], p[1]);
#pragma unroll
    for (int e = 0; e < 2; ++e) { u32x4 o;
        o.x = e ? ((vr[0] >> 16) | (vr[1] & 0xffff0000u)) : ((vr[0] & 0xffffu) | (vr[1] << 16)); o.y = e ? ((vr[2] >> 16) | (vr[3] & 0xffff0000u)) : ((vr[2] & 0xffffu) | (vr[3] << 16));
        o.z = e ? ((vr[4] >> 16) | (vr[5] & 0xffff0000u)) : ((vr[4] & 0xffffu) | (vr[5] << 16)); o.w = e ? ((vr[6] >> 16) | (vr[7] & 0xffff0000u)) : ((vr[6] & 0xffffu) | (vr[7] << 16));
        *(LAS u32x4*)(lds + L_VT + off128(2 * cp + e, tg)) = o; }
    __syncthreads();
#pragma unroll
    for (int dir = 0; dir < 2; ++dir) {
        float sub[4][2], R[2], Tot[2];
        gate_global(cp, tg, dir, lds, p[dir], sub, R, Tot);
#pragma unroll
        for (int e = 0; e < 2; ++e) { float k4[8];
#pragma unroll
            for (int j = 0; j < 8; ++j) k4[j] = kk[dir][j][e] * __expf(Tot[e] - R[e] - p[dir][j][e]);
            u32x4 o; o.x = pkbf(k4[0], k4[1]); o.y = pkbf(k4[2], k4[3]); o.z = pkbf(k4[4], k4[5]); o.w = pkbf(k4[6], k4[7]);
            *(LAS u32x4*)(lds + L_KT + dir * 16384 + off128(2 * cp + e, tg)) = o;
            if (tg == 0) DC[(size_t)sidx(gc, h, dir) * 128 + 2 * cp + e] = __expf(Tot[e]); }
    }
    __syncthreads();
    if (has_next) pass_a_load(pre, ngc, nh, ZF, ZB, tid);
#pragma unroll
    for (int dir = 0; dir < 2; ++dir) {
        f32x4 acc[8];
#pragma unroll
        for (int n = 0; n < 8; ++n) acc[n] = (f32x4){0.f, 0.f, 0.f, 0.f};
#pragma unroll
        for (int ks = 0; ks < 2; ++ks) { const bf16x8 a = *(const LAS bf16x8*)(lds + L_KT + dir * 16384 + off128(16 * w + fr, 4 * ks + fq));
#pragma unroll
            for (int n = 0; n < 8; ++n) { const bf16x8 b = *(const LAS bf16x8*)(lds + L_VT + off128(16 * n + fr, 4 * ks + fq)); acc[n] = __builtin_amdgcn_mfma_f32_16x16x32_bf16(a, b, acc[n], 0, 0, 0); } }
        u16* st = ST + (size_t)sidx(gc, h, dir) * 16384 + 16 * w + 4 * fq;
#pragma unroll
        for (int n = 0; n < 8; ++n) { u32x2_t o; o.x = pkbf(acc[n][0], acc[n][1]); o.y = pkbf(acc[n][2], acc[n][3]); *(u32x2_t*)(st + (16 * n + fr) * 128) = o; }
    }
    __syncthreads();
}

__device__ __forceinline__ void pass_b_item(int item, u16* ST, const float* DC, int tid) {
    const int chain = item >> 2, quarter = item & 3, seq = (chain >> 5) ^ 1, dir = (chain >> 4) & 1, h = chain & 15;
    const int n = seq ? 256 : 128, gc0 = seq ? 128 : 0, e16 = quarter * 512 + tid, k0 = (e16 & 15) * 8;
    float S[8];
#pragma unroll
    for (int i = 0; i < 8; ++i) S[i] = 0.f;
    for (int s0 = 0; s0 < n; s0 += 8) {
        u32x4 d[8]; f32x4 da[8], db[8]; u32x4* sp[8];
#pragma unroll
        for (int u = 0; u < 8; ++u) { const int c = dir ? n - 1 - (s0 + u) : s0 + u; const size_t si = (size_t)sidx(gc0 + c, h, dir);
            sp[u] = (u32x4*)(ST + si * 16384) + e16; d[u] = *sp[u]; da[u] = *(const f32x4*)(DC + si * 128 + k0); db[u] = *(const f32x4*)(DC + si * 128 + k0 + 4); }
#pragma unroll
        for (int u = 0; u < 8; ++u) {
            u32x4 o; o.x = pkbf(S[0], S[1]); o.y = pkbf(S[2], S[3]); o.z = pkbf(S[4], S[5]); o.w = pkbf(S[6], S[7]); *sp[u] = o;
            S[0] = da[u][0] * S[0] + bflo(d[u].x); S[1] = da[u][1] * S[1] + bfhi(d[u].x); S[2] = da[u][2] * S[2] + bflo(d[u].y); S[3] = da[u][3] * S[3] + bfhi(d[u].y);
            S[4] = db[u][0] * S[4] + bflo(d[u].z); S[5] = db[u][1] * S[5] + bfhi(d[u].z); S[6] = db[u][2] * S[6] + bflo(d[u].w); S[7] = db[u][3] * S[7] + bfhi(d[u].w); }
    }
}

struct CPre { unsigned zf[8]; };
__device__ __forceinline__ void pass_c_load(CPre& p, int gc, int h, const u16* ZF, int tid) {
    const int cp = tid & 63, tg = __builtin_amdgcn_readfirstlane(tid >> 6);
    const size_t row0 = (size_t)(gc >= 128 ? T0 + (gc - 128) * 64 : gc * 64);
    const size_t rowoff = (row0 + 8 * tg) * HGW + h * 128 + 2 * cp;
#pragma unroll
    for (int j = 0; j < 8; ++j) p.zf[j] = *(const unsigned*)(ZF + rowoff + (size_t)j * HGW);
}
__device__ __forceinline__ void pass_c_item(CPre& pre, int ngc, int nh, bool has_next, int gc, int h, u16* HQ, const u16* ZF, const u16* ZB, const u16* HI, const u16* HOG, const float* lbf, const float* lbb, const float* hgw,
                                            const u16* ST, LAS unsigned char* lds, int tid) {
    const int cp = tid & 63, tg = __builtin_amdgcn_readfirstlane(tid >> 6), lane = tid & 63, fr = lane & 15, fq = lane >> 4, w = tg;
    const size_t row0 = (size_t)(gc >= 128 ? T0 + (gc - 128) * 64 : gc * 64);
    const size_t rowoff = (row0 + 8 * tg) * HGW + h * 128 + 2 * cp;
    unsigned qr[8], vr[8], zz[2][8];
#pragma unroll
    for (int j = 0; j < 8; ++j) { zz[0][j] = pre.zf[j]; vr[j] = *(const unsigned*)(HI + rowoff + (size_t)j * HGW); qr[j] = *(const unsigned*)(HQ + rowoff + (size_t)j * HGW); zz[1][j] = *(const unsigned*)(ZB + rowoff + (size_t)j * HGW); }
    f32x4 oacc[4];
#pragma unroll
    for (int mi = 0; mi < 4; ++mi) oacc[mi] = (f32x4){0.f, 0.f, 0.f, 0.f};
#pragma unroll 1
    for (int dir = 0; dir < 2; ++dir) {
        bf16x8 sf[4];
#pragma unroll
        for (int ks = 0; ks < 4; ++ks) sf[ks] = *(const bf16x8*)(ST + (size_t)sidx(gc, h, dir) * 16384 + (16 * w + fr) * 128 + 32 * ks + 8 * fq);
        float kk[8][2], p[8][2];
        if (dir == 0) gate_local(zz[0], lbf + h * 128, cp, tg, 0, lds, kk, p); else gate_local(zz[1], lbb + h * 128, cp, tg, 1, lds, kk, p);
        if (dir == 0) {
#pragma unroll
    for (int e = 0; e < 2; ++e) { u32x4 o;
        o.x = e ? ((vr[0] >> 16) | (vr[1] & 0xffff0000u)) : ((vr[0] & 0xffffu) | (vr[1] << 16)); o.y = e ? ((vr[2] >> 16) | (vr[3] & 0xffff0000u)) : ((vr[2] & 0xffffu) | (vr[3] << 16));
        o.z = e ? ((vr[4] >> 16) | (vr[5] & 0xffff0000u)) : ((vr[4] & 0xffffu) | (vr[5] << 16)); o.w = e ? ((vr[6] >> 16) | (vr[7] & 0xffff0000u)) : ((vr[6] & 0xffffu) | (vr[7] << 16));
        *(LAS u32x4*)(lds + L_VT + off128(2 * cp + e, tg)) = o; }
        }
        __syncthreads();
        float sub[4][2], R[2], Tot[2];
        gate_global(cp, tg, dir, lds, p, sub, R, Tot);
        const int I = tg >> 1;
        float eR[2], F[4][2];
#pragma unroll
        for (int e = 0; e < 2; ++e) { eR[e] = __expf(R[e]);
#pragma unroll
            for (int Ir = 0; Ir < 4; ++Ir) { float d = 0.f;
#pragma unroll
                for (int i2 = 0; i2 < 4; ++i2) { const bool between = dir ? (i2 <= I && i2 > Ir) : (i2 >= I && i2 < Ir); d += between ? sub[i2][e] : 0.f; }
                const bool after = dir ? (Ir < I) : (Ir > I);
                F[Ir][e] = (Ir == I) ? 1.0f : (after ? __expf(d) : 0.0f); } }
#pragma unroll
        for (int j = 0; j < 8; ++j) { const int i = 8 * tg + j;
            const float q0 = bflo(qr[j]), q1 = bfhi(qr[j]);
            const float ea0 = __expf(p[j][0]), ea1 = __expf(p[j][1]);
            const float qt0 = q0 * ea0, qt1 = q1 * ea1;
            *(LAS unsigned*)(lds + L_QT + off256(i, cp >> 2) + (cp & 3) * 4) = pkbf(qt0, qt1);
            *(LAS unsigned*)(lds + L_QB + off256(i, cp >> 2) + (cp & 3) * 4) = pkbf(qt0 * eR[0], qt1 * eR[1]);
            const float kd0 = kk[j][0] * __expf(fminf(-p[j][0], 80.f)), kd1 = kk[j][1] * __expf(fminf(-p[j][1], 80.f));
#pragma unroll
            for (int Ir = 0; Ir < 4; ++Ir) *(LAS unsigned*)(lds + L_KT + Ir * 16384 + off256(i, cp >> 2) + (cp & 3) * 4) = pkbf(kd0 * F[Ir][0], kd1 * F[Ir][1]); }
        __syncthreads();
        { const int Ib = w >> 1;
#pragma unroll
          for (int jj = 0; jj < 2; ++jj) { const int J = 2 * (w & 1) + jj; f32x4 sc = (f32x4){0.f, 0.f, 0.f, 0.f};
#pragma unroll
            for (int ks = 0; ks < 4; ++ks) { const bf16x8 a = *(const LAS bf16x8*)(lds + L_QT + off256(16 * Ib + fr, 4 * ks + fq));
                const bf16x8 b = *(const LAS bf16x8*)(lds + L_KT + Ib * 16384 + off256(16 * J + fr, 4 * ks + fq)); sc = __builtin_amdgcn_mfma_f32_16x16x32_bf16(a, b, sc, 0, 0, 0); }
#pragma unroll
            for (int r = 0; r < 4; ++r) { const int il = 4 * fq + r; float v = sc[r];
                if (J == Ib) { const bool keep = dir ? (fr >= il) : (fr <= il); v = keep ? v : 0.f; }
                const int row = 16 * Ib + il, col = 16 * J + fr;
                *(LAS u16*)(lds + L_P + off128(row, col >> 3) + (col & 7) * 2) = (u16)(pkbf(v, 0.f) & 0xffffu); } } }
        __syncthreads();
#pragma unroll
        for (int ks = 0; ks < 4; ++ks) { const bf16x8 b = sf[ks];
#pragma unroll
            for (int mi = 0; mi < 4; ++mi) { const bf16x8 a = *(const LAS bf16x8*)(lds + L_QB + off256(16 * mi + fr, 4 * ks + fq)); oacc[mi] = __builtin_amdgcn_mfma_f32_16x16x32_bf16(a, b, oacc[mi], 0, 0, 0); } }
#pragma unroll
        for (int ks = 0; ks < 2; ++ks) { const bf16x8 b = *(const LAS bf16x8*)(lds + L_VT + off128(16 * w + fr, 4 * ks + fq));
#pragma unroll
            for (int mi = 0; mi < 4; ++mi) { const bf16x8 a = *(const LAS bf16x8*)(lds + L_P + off128(16 * mi + fr, 4 * ks + fq)); oacc[mi] = __builtin_amdgcn_mfma_f32_16x16x32_bf16(a, b, oacc[mi], 0, 0, 0); } }
        __syncthreads();
    }
#pragma unroll
    for (int mi = 0; mi < 4; ++mi)
#pragma unroll
        for (int r = 0; r < 4; ++r) { float sq = oacc[mi][r] * oacc[mi][r];
            sq += __shfl_xor(sq, 1); sq += __shfl_xor(sq, 2); sq += __shfl_xor(sq, 4); sq += __shfl_xor(sq, 8);
            if (fr == 0) ((LAS float*)(lds + L_RED))[w * 64 + 16 * mi + 4 * fq + r] = sq; }
    __syncthreads();
    if (has_next) pass_c_load(pre, ngc, nh, ZF, tid);
    u32x4 hogr[2];
#pragma unroll
    for (int c2 = 0; c2 < 2; ++c2) { const int id = tid + 512 * c2; hogr[c2] = *(const u32x4*)(HOG + (row0 + (id >> 4)) * HGW + h * 128 + (id & 15) * 8); }
    if (tid < 64) { float t = 0.f;
#pragma unroll
        for (int ww = 0; ww < 8; ++ww) t += ((const LAS float*)(lds + L_RED))[ww * 64 + tid];
        ((LAS float*)(lds + L_RSTD))[tid] = 1.0f / sqrtf(t * (1.0f / 128.0f) + EPS); }
    __syncthreads();
    { const float wv = hgw[h * 128 + 16 * w + fr];
#pragma unroll
      for (int mi = 0; mi < 4; ++mi)
#pragma unroll
        for (int r = 0; r < 4; ++r) { const int i = 16 * mi + 4 * fq + r; ((LAS float*)(lds + L_OUT))[i * 128 + 16 * w + fr] = oacc[mi][r] * ((const LAS float*)(lds + L_RSTD))[i] * wv; } }
    __syncthreads();
#pragma unroll
    for (int c2 = 0; c2 < 2; ++c2) { const int id = tid + 512 * c2, i = id >> 4, vc = (id & 15) * 8;
        const f32x4 y0 = *(const LAS f32x4*)(lds + L_OUT + (i * 128 + vc) * 4), y1 = *(const LAS f32x4*)(lds + L_OUT + (i * 128 + vc + 4) * 4);
        const size_t go = (row0 + i) * HGW + h * 128 + vc; const u32x4 g = hogr[c2];
        u32x4 o; o.x = pkbf(y0[0] * bflo(g.x), y0[1] * bfhi(g.x)); o.y = pkbf(y0[2] * bflo(g.y), y0[3] * bfhi(g.y)); o.z = pkbf(y1[0] * bflo(g.z), y1[1] * bfhi(g.z)); o.w = pkbf(y1[2] * bflo(g.w), y1[3] * bfhi(g.w));
        *(u32x4*)(HQ + go) = o; }
    __syncthreads();
}
}

__device__ __forceinline__ void tr_item(const float* W, int K, int N, u16* WT, LAS float* scr, int item, int lane, bool gu) {
    const int nblk = N / 32, kb = item / nblk, nb = item % nblk, k0 = 64 * kb, n0 = 32 * nb;
    float wv_[32];
#pragma unroll
    for (int i = 0; i < 32; ++i) wv_[i] = W[(size_t)(k0 + 2 * i + (lane >> 5)) * N + n0 + (lane & 31)];
#pragma unroll
    for (int i = 0; i < 32; ++i) scr[(2 * i + (lane >> 5)) * 33 + (lane & 31)] = wv_[i];
    LDS_WAIT(); asm volatile("" ::: "memory");
    int r0 = n0;
    if (gu) { const int isu = n0 >= DFF ? 1 : 0, nn = n0 - isu * DFF; r0 = (nn >> 7) * 256 + isu * 128 + (nn & 127); }
    const int c = lane & 7;
#pragma unroll
    for (int j = 0; j < 4; ++j) { const int n = (lane >> 3) + 8 * j; const LAS float* s = scr + (8 * c) * 33 + n;
        v4u o; o.x = pkbf(s[0 * 33], s[1 * 33]); o.y = pkbf(s[2 * 33], s[3 * 33]); o.z = pkbf(s[4 * 33], s[5 * 33]); o.w = pkbf(s[6 * 33], s[7 * 33]);
        *(GAS v4u*)(WT + (size_t)(r0 + n) * K + k0 + 8 * c) = o; }
    LDS_WAIT(); asm volatile("" ::: "memory");
}
__device__ __forceinline__ void rms_row(const float* xrow, const float* w, u16* ob, float* of, int lane) {
    const f32x4* xr = (const f32x4*)xrow + lane; const f32x4* wr = (const f32x4*)w + lane;
    f32x4 v[16], wv[16]; float s = 0.f;
#pragma unroll
    for (int j = 0; j < 16; ++j) v[j] = xr[64 * j];
#pragma unroll
    for (int j = 0; j < 16; ++j) wv[j] = wr[64 * j];
#pragma unroll
    for (int j = 0; j < 16; ++j) s += (v[j].x * v[j].x + v[j].y * v[j].y) + (v[j].z * v[j].z + v[j].w * v[j].w);
    const float rstd = 1.0f / sqrtf(wave_sum(s) * (1.0f / DM) + EPS);
#pragma unroll
    for (int j = 0; j < 16; ++j) { const f32x4 o = (v[j] * rstd) * wv[j];
        if (ob) { u32x2_t p; p.x = pkbf(o.x, o.y); p.y = pkbf(o.z, o.w); ((u32x2_t*)ob)[lane + 64 * j] = p; }
        else ((f32x4*)of)[lane + 64 * j] = o; }
}
template <bool ADD> __device__ __forceinline__ void rms_row_b16(const u16* xrow, const u16* arow, const float* w, u16* ob, float* of, int lane) {
    const pg8::u32x4* xr = (const pg8::u32x4*)xrow + lane; const pg8::u32x4* ar = (const pg8::u32x4*)arow + lane; const f32x4* wr = (const f32x4*)w + 2 * lane;
    pg8::u32x4 v[8], va[8]; f32x4 wv[8][2]; float s = 0.f;
#pragma unroll
    for (int j = 0; j < 8; ++j) v[j] = xr[64 * j];
    if constexpr (ADD) {
#pragma unroll
        for (int j = 0; j < 8; ++j) va[j] = ar[64 * j]; }
#pragma unroll
    for (int j = 0; j < 8; ++j) { wv[j][0] = wr[128 * j]; wv[j][1] = wr[128 * j + 1]; }
    float f[8][8];
#pragma unroll
    for (int j = 0; j < 8; ++j) { f[j][0] = bflo(v[j].x); f[j][1] = bfhi(v[j].x); f[j][2] = bflo(v[j].y); f[j][3] = bfhi(v[j].y); f[j][4] = bflo(v[j].z); f[j][5] = bfhi(v[j].z); f[j][6] = bflo(v[j].w); f[j][7] = bfhi(v[j].w);
        if constexpr (ADD) { f[j][0] += bflo(va[j].x); f[j][1] += bfhi(va[j].x); f[j][2] += bflo(va[j].y); f[j][3] += bfhi(va[j].y); f[j][4] += bflo(va[j].z); f[j][5] += bfhi(va[j].z); f[j][6] += bflo(va[j].w); f[j][7] += bfhi(va[j].w); }
#pragma unroll
        for (int e = 0; e < 8; ++e) s += f[j][e] * f[j][e]; }
    const float rstd = 1.0f / sqrtf(wave_sum(s) * (1.0f / DM) + EPS);
#pragma unroll
    for (int j = 0; j < 8; ++j) { pg8::u32x4 o;
        if (!ob) { f32x4 a = {f[j][0], f[j][1], f[j][2], f[j][3]}, b = {f[j][4], f[j][5], f[j][6], f[j][7]};
            ((f32x4*)of)[2 * (lane + 64 * j)] = (a * rstd) * wv[j][0]; ((f32x4*)of)[2 * (lane + 64 * j) + 1] = (b * rstd) * wv[j][1]; continue; }
        o.x = pkbf(f[j][0] * rstd * wv[j][0].x, f[j][1] * rstd * wv[j][0].y); o.y = pkbf(f[j][2] * rstd * wv[j][0].z, f[j][3] * rstd * wv[j][0].w);
        o.z = pkbf(f[j][4] * rstd * wv[j][1].x, f[j][5] * rstd * wv[j][1].y); o.w = pkbf(f[j][6] * rstd * wv[j][1].z, f[j][7] * rstd * wv[j][1].w);
        ((pg8::u32x4*)ob)[lane + 64 * j] = o; }
}
__device__ __forceinline__ void k_norm_rope(u16* AK, const float* knw, int gw, int NGW, int lane) {
    const float inv = exp2f(-(float)(lane & 31) * 0.41524101186092029f);
    const float w0 = knw[2 * lane], w1 = knw[2 * lane + 1];
    for (int it = gw; it < M * 4; it += NGW) {
        const int m = it >> 2, kvh = it & 3; unsigned* p = (unsigned*)(AK + (size_t)m * KVW + kvh * 128) + lane;
        const unsigned raw = *p; const float a = bflo(raw), b = bfhi(raw);
        const float rstd = 1.0f / sqrtf(wave_sum(a * a + b * b) * (1.0f / 128.0f) + EPS);
        const int pos = m < T0 ? m : m - T0; const float ang = (lane < 32 ? (float)(pos >> 6) : (float)(pos & 63)) * inv;
        const float sn = __sinf(ang), cs = __cosf(ang), x0 = a * rstd * w0, x1 = b * rstd * w1;
        *p = pkbf(x0 * cs - x1 * sn, x0 * sn + x1 * cs);
    }
}
#ifndef GEMM_ALIGN
#define GEMM_ALIGN true
#endif
#ifndef GEMM_SP2
#define GEMM_SP2 true
#endif
#define GEMM_RUN(EPI) pg8::gemm_phase<EPI, pg8::StaticOrder, GEMM_ALIGN, GEMM_SP2>
constexpr int NPH = 12;
constexpr int I_GU = (DM / 64) * (2 * DFF / 32), I_DN = (DFF / 64) * (DM / 32), I_A = (HGW / 64) * (DM / 32), I_O = (DM / 64) * (DM / 32);
#ifndef I_GU_TAIL
#define I_GU_TAIL 28672
#endif
constexpr size_t WS_DC = WS_END, WS_NEED = WS_END + 8 * MiB;
struct Args { const float* in[16]; float* out; unsigned char* ws; int ph_lo, ph_hi; };
__global__ void __launch_bounds__(NWAVES * 64, 2) fwd_kernel(Args args) {
    extern __shared__ __attribute__((aligned(16))) unsigned char lds[];
    LAS unsigned char* ldsl = (LAS unsigned char*)lds;
    volatile LAS unsigned* MISC = (volatile LAS unsigned*)(ldsl + MISC_OFF);
    const int wave = __builtin_amdgcn_readfirstlane((int)threadIdx.x >> 6);
    const int G = gridDim.x; const int bx = blockIdx.x; const int vcu = (G % 8 == 0) ? (bx % 8) * (G / 8) + bx / 8 : bx;
    const int gw = vcu * NWAVES + wave, NGW = G * NWAVES;
    unsigned char* ws = args.ws; unsigned char* dob = (unsigned char*)args.out;
    float* const outp = args.out;
    gu32* ctl = (gu32*)(ws + WS_CTL);
    for (int u = threadIdx.x; u < (LDS_BYTES - 131072) / 4; u += NWAVES * 64) ((LAS unsigned*)(ldsl + 131072))[u] = 0u;
    __syncthreads();
    XcdBarrier bar = xcd_barrier_post((unsigned*)(ctl + CW_BAR), MISC + 8);
    const int lo = args.ph_lo, hi = args.ph_hi;
#define IN(k) (lo <= (k) && (k) < hi)
#define SEAM(k) do { if (IN((k) + 1)) xcd_barrier(bar); } while (0)
#define WIN_t ((u16*)(dol + DO_WIN))
#define Hn ((u16*)(dol + DO_H))
#define WA_t ((u16*)(wsl + WS_WA))
#define WB_t ((u16*)(wsl + WS_WB))
#define WOUT_t ((u16*)(wsl + WS_WOUT))
#define WGU_t ((u16*)(wsl + WS_WGU))
#define WDN_t ((u16*)(wsl + WS_WDN))
#define PHASE_PTRS size_t zof_ = 0; int zph = 0; int tidl_ = threadIdx.x; asm volatile("" : "+s"(zof_), "+s"(zph), "+v"(tidl_)); \
    unsigned char* wsl = ws + zof_; unsigned char* dol = dob + zof_;     \
    const int tid = tidl_, lane = tidl_ & 63; (void)tid; (void)lane
#define INP(k) (args.in[(k) + zph])

    if (IN(0)) { PHASE_PTRS;
        LAS float* scr = (LAS float*)(ldsl + wave * 16384);
        constexpr int I_IN = (DM / 64) * (INW / 32);
        constexpr int NITEMS = I_IN + 2 * I_A + I_O + (I_GU - I_GU_TAIL);
        for (int it = gw; it < NITEMS; it += NGW) {
            int r = it;
            if (r < I_IN) { tr_item(INP(3), DM, INW, WIN_t, scr, r, lane, false); continue; } r -= I_IN;
            if (r < I_A) { tr_item(INP(9), HGW, DM, WA_t, scr, r, lane, false); continue; } r -= I_A;
            if (r < I_A) { tr_item(INP(10), AW, DM, WB_t, scr, r, lane, false); continue; } r -= I_A;
            if (r < I_O) { tr_item(INP(11), DM, DM, WOUT_t, scr, r, lane, false); continue; } r -= I_O;
            tr_item(INP(13), DM, 2 * DFF, WGU_t, scr, I_GU_TAIL + r, lane, true);
        }
        for (int m = gw; m < M; m += NGW) rms_row(m < T0 ? INP(0) + (size_t)m * DM : INP(1) + (size_t)(m - T0) * DM, INP(2), Hn + (size_t)m * DM, nullptr, lane);
        SEAM(0);
    }
    if (IN(1)) { PHASE_PTRS;
        pg8::Gemm g{Hn, WIN_t, M, INW, DM}; pg8::StaticOrder S; S.init(M, INW, G, bx);
        EpiInProj E{wsl};
        GEMM_RUN(EpiInProj)(ldsl, g, S, E);
        { LAS float* scr = (LAS float*)(ldsl + wave * 16384); const bool split = (G == 256); const int w0 = split ? (bx - 128) * NWAVES + wave : bx * NWAVES + wave, nw = split ? 128 * NWAVES : G * NWAVES;
          int tl2_ = threadIdx.x; asm volatile("" : "+v"(tl2_));
          if (!split || bx >= 128) for (int it = w0; it < I_GU_TAIL; it += nw) tr_item(INP(13), DM, 2 * DFF, WGU_t, scr, it, tl2_ & 63, true); }
        SEAM(1);
    }
    if (IN(2)) { PHASE_PTRS;
        k_norm_rope((u16*)(wsl + WS_AK), INP(8), gw, NGW, lane);
        { hg::APre apre;
          if (vcu < 6144) hg::pass_a_load(apre, vcu >> 4, vcu & 15, (const u16*)(wsl + WS_ZF), (const u16*)(wsl + WS_ZB), tid);
          for (int it = vcu; it < 6144; it += G) { const int nit = it + G;
            hg::pass_a_item(apre, nit >> 4, nit & 15, nit < 6144, it >> 4, it & 15, (const u16*)(wsl + WS_ZF), (const u16*)(wsl + WS_ZB), (const u16*)(wsl + WS_HI), INP(4), INP(5), (u16*)dol, (float*)(wsl + WS_DC), ldsl, tid); } }
        SEAM(2);
    }
    if (IN(3)) { PHASE_PTRS;
        for (int item = vcu; item < 256; item += G) hg::pass_b_item(item, (u16*)dol, (const float*)(wsl + WS_DC), tid);
        SEAM(3);
    }
    if (IN(4)) { PHASE_PTRS;
        { hg::CPre cpre;
          if (vcu < 6144) hg::pass_c_load(cpre, vcu >> 4, vcu & 15, (const u16*)(wsl + WS_ZF), tid);
          for (int it = vcu; it < 6144; it += G) { const int nit = it + G;
            hg::pass_c_item(cpre, nit >> 4, nit & 15, nit < 6144, it >> 4, it & 15, (u16*)(wsl + WS_HQ), (const u16*)(wsl + WS_ZF), (const u16*)(wsl + WS_ZB), (const u16*)(wsl + WS_HI), (const u16*)(wsl + WS_HOG), INP(4), INP(5), INP(6), (const u16*)dol, ldsl, tid); } }
        float negBl2;
        { int tl_ = threadIdx.x; asm volatile("" : "+v"(tl_)); const int ln = tl_ & 63;
          const float* qw = INP(7); const float* kw = INP(8); float a = fmaxf(fabsf(qw[2 * ln]), fabsf(qw[2 * ln + 1])), k2 = fmaxf(fabsf(kw[2 * ln]), fabsf(kw[2 * ln + 1]));
#pragma unroll
          for (int o = 1; o < 64; o <<= 1) { a = fmaxf(a, __shfl_xor(a, o)); k2 = fmaxf(k2, __shfl_xor(k2, o)); }
          negBl2 = __uint_as_float(__builtin_amdgcn_readfirstlane(__float_as_uint(-1.4426950408889634f * 11.313708498984761f * a * k2))); }
        u16* AQ = (u16*)(wsl + WS_AQ); const u16* AK = (const u16*)(wsl + WS_AK); const u16* AV = (const u16*)(wsl + WS_AV);
#define ATT_UNITS(SH) for (int idx = vcu; idx < 1536; idx += G) {            \
            int seq, kvh, qh, qb; \
            if (idx < 1024) { seq = 1; kvh = idx >> 8; const int rem = idx & 255; qh = kvh * 4 + (rem >> 6); qb = rem & 63; } \
            else { const int j = idx - 1024; seq = 0; kvh = j >> 7; const int rem = j & 127; qh = kvh * 4 + (rem >> 5); qb = rem & 31; } \
            const size_t rowbase = seq ? T0 : 0; \
            att::attn_unit<SH>(AQ + (rowbase + (size_t)qb * 256) * AW + qh * 128, AK + rowbase * KVW + kvh * 128, AV + rowbase * KVW + kvh * 128, INP(7), qb * 256, seq ? T1 : T0, negBl2, (char*)lds); }
        if (negBl2 >= -60.0f) { ATT_UNITS(false) } else { ATT_UNITS(true) }
#undef ATT_UNITS
        SEAM(4);
    }
    if (IN(5)) { PHASE_PTRS;
        pg8::Gemm g{(const u16*)(wsl + WS_HQ), WA_t, M, DM, HGW}; pg8::StaticOrder S; S.init(M, DM, G, bx);
        EpiGate<false> E{(const u16*)(wsl + WS_GA), nullptr, (u16*)(wsl + WS_T)};
        GEMM_RUN(EpiGate<false>)(ldsl, g, S, E);
        if (IN(6)) { __builtin_amdgcn_fence(__ATOMIC_ACQUIRE, "agent"); asm volatile("s_waitcnt vmcnt(0)" ::: "memory"); __syncthreads(); }
    }
    if (IN(6)) { PHASE_PTRS;
        pg8::Gemm g{(const u16*)(wsl + WS_AQ), WB_t, M, DM, AW}; pg8::StaticOrder S; S.init(M, DM, G, bx);
        EpiGate<true> E{(const u16*)(wsl + WS_GB), (const u16*)(wsl + WS_T), (u16*)(wsl + WS_MERGED)};
        GEMM_RUN(EpiGate<true>)(ldsl, g, S, E);
        SEAM(6);
    }
    if (IN(7)) { PHASE_PTRS;
        pg8::Gemm g{(const u16*)(wsl + WS_MERGED), WOUT_t, M, DM, DM}; pg8::StaticOrder S; S.init(M, DM, G, bx);
        EpiResToB16 E{INP(0), INP(1), (u16*)(wsl + WS_X1B)};
        GEMM_RUN(EpiResToB16)(ldsl, g, S, E);
        SEAM(7);
    }
    if (IN(8)) { PHASE_PTRS;
        for (int m = gw; m < M; m += NGW) rms_row_b16<false>((const u16*)(wsl + WS_X1B) + (size_t)m * DM, nullptr, INP(12), (u16*)(wsl + WS_XN2) + (size_t)m * DM, nullptr, lane);
        SEAM(8);
    }
    if (IN(9)) { PHASE_PTRS;
        pg8::Gemm g{(const u16*)(wsl + WS_XN2), WGU_t, M, 2 * DFF, DM}; pg8::StaticOrder S; S.init(M, 2 * DFF, G, bx);
        EpiSwiGLU E{(u16*)(wsl + WS_ACT)};
        GEMM_RUN(EpiSwiGLU)(ldsl, g, S, E);
        { LAS float* scr = (LAS float*)(ldsl + wave * 16384); const bool split = (G == 256); const int w0 = split ? (bx - 64) * NWAVES + wave : bx * NWAVES + wave, nw = split ? 192 * NWAVES : G * NWAVES;
          int tl2_ = threadIdx.x; asm volatile("" : "+v"(tl2_));
          if (!split || bx >= 64) for (int it = w0; it < I_DN; it += nw) tr_item(INP(14), DFF, DM, WDN_t, scr, it, tl2_ & 63, false); }
        SEAM(9);
    }
    if (IN(10)) { PHASE_PTRS;
        pg8::Gemm g{(const u16*)(wsl + WS_ACT), WDN_t, M, DM, DFF}; pg8::StaticOrder S; S.init(M, DM, G, bx);
        EpiPlainB16 E{(u16*)(wsl + WS_X2B)};
        GEMM_RUN(EpiPlainB16)(ldsl, g, S, E);
        SEAM(10);
    }
    if (IN(11)) { PHASE_PTRS;
        for (int m = gw; m < M; m += NGW) rms_row_b16<true>((const u16*)(wsl + WS_X1B) + (size_t)m * DM, (const u16*)(wsl + WS_X2B) + (size_t)m * DM, INP(15), nullptr, outp + (size_t)m * DM, lane);
    }
#undef IN
#undef SEAM
#undef INP
#undef PHASE_PTRS
#undef WIN_t
#undef Hn
#undef WA_t
#undef WB_t
#undef WOUT_t
#undef WGU_t
#undef WDN_t
}

#ifndef MK_N_LAUNCHES
#define MK_N_LAUNCHES 1
#endif
extern "C" void kernel_launch(void* const* d_in, const int* in_sizes, int n_in, void* d_out, int out_size, void* d_ws, size_t ws_size, hipStream_t stream) {
    static int grid = 0;
    if (grid == 0) {
        if (n_in != 16 || in_sizes[0] != T0 * DM || in_sizes[1] != T1 * DM || out_size != M * DM || ws_size < WS_NEED) {
            fprintf(stderr, "kernel_launch: shape mismatch (n_in %d, out %d, ws %zu); nothing launched\n", n_in, out_size, ws_size); grid = -1; return; }
        int dev = 0, cus = 0, per_cu = 0;
        if (hipGetDevice(&dev) != hipSuccess || hipDeviceGetAttribute(&cus, hipDeviceAttributeMultiprocessorCount, dev) != hipSuccess) { grid = -1; return; }
        if (hipFuncSetAttribute((const void*)fwd_kernel, hipFuncAttributeMaxDynamicSharedMemorySize, LDS_BYTES) != hipSuccess) { fprintf(stderr, "kernel_launch: hipFuncSetAttribute failed\n"); grid = -1; return; }
        if (hipOccupancyMaxActiveBlocksPerMultiprocessor(&per_cu, (const void*)fwd_kernel, NWAVES * 64, LDS_BYTES) != hipSuccess || per_cu < 1) { fprintf(stderr, "kernel_launch: occupancy query says %d\n", per_cu); grid = -1; (void)hipGetLastError(); return; }
        grid = cus;
    }
    if (grid < 0) return;
    if (hipMemsetAsync((char*)d_ws + WS_CTL, 0, CTL_ZERO_BYTES, stream) != hipSuccess) return;
    Args a{};
    for (int i = 0; i < 16; ++i) a.in[i] = (const float*)d_in[i];
    a.out = (float*)d_out; a.ws = (unsigned char*)d_ws;
    if (MK_N_LAUNCHES == 1) { a.ph_lo = 0; a.ph_hi = NPH; hipLaunchKernelGGL(fwd_kernel, dim3(grid), dim3(NWAVES * 64), LDS_BYTES, stream, a); }
    else for (int p = 0; p < NPH; ++p) { a.ph_lo = p; a.ph_hi = p + 1; hipLaunchKernelGGL(fwd_kernel, dim3(grid), dim3(NWAVES * 64), LDS_BYTES, stream, a); }
    const hipError_t le = hipPeekAtLastError();
    if (le != hipSuccess) fprintf(stderr, "kernel_launch: launch failed: %s\n", hipGetErrorName(le));
}
```

```cpp
#include <hip/hip_runtime.h>
#include <cstdio>
#include <cstdint>
namespace pg8 {
#define PG8_LAS __attribute__((address_space(3)))
typedef unsigned short bf16_t;
typedef short bf16x8 __attribute__((ext_vector_type(8)));
typedef float f32x4 __attribute__((ext_vector_type(4)));
typedef unsigned u32x4 __attribute__((ext_vector_type(4)));
constexpr int BM = 256, BK = 64, HALF = 128, HTB = HALF * BK * 2  , STAGE_BYTES = 8 * HTB, NXCD = 8, WGM = 4;

__host__ __device__ __forceinline__ int lds_byte(int r, int c) { const int st = (r >> 4) * 2 + (c >> 5), rr = r & 15, cc = c & 31, ob = rr * 64 + cc * 2; return st * 1024 + (ob ^ (((ob >> 9) & 1) << 5)); }
__host__ __device__ __forceinline__ void stage_rc(int b, int& R, int& C) { const int st = b / 1024, sb = b % 1024, swz = sb ^ (((sb >> 9) & 1) << 5); R = (st >> 1) * 16 + swz / 64; C = (st & 1) * 32 + (swz % 64) / 2; }
__host__ __device__ __forceinline__ int perm32(int rho) { const int n = rho >> 4, i = rho & 15; return 8 * (i >> 2) + 4 * n + (i & 3); }

struct Unit { int pm, pn; };
struct Gemm { const bf16_t* A; const bf16_t* Bt; int M, N, K; };

struct StaticOrder {
    int nM, nN, nwg, G, c, wgm;
    __host__ __device__ void init(int M, int N, int G_, int c_, int wgm_ = WGM) { nM = M / BM; nN = N / BM; nwg = nM * nN; G = G_; c = c_; wgm = wgm_; }
    __host__ __device__ bool next(int i, Unit& u) const {
        const long L = (long)i * G + c; if (L >= nwg) return false;
        int wgid = (int)L; { const int q = nwg / NXCD, r = nwg % NXCD, xcd = wgid % NXCD, off = wgid / NXCD; wgid = (xcd < r ? xcd * (q + 1) : r * (q + 1) + (xcd - r) * q) + off; }
        const int nig = wgm * nN, gid = wgid / nig, fm = gid * wgm, gsz = (nM - fm) < wgm ? (nM - fm) : wgm;
        u.pm = fm + ((wgid % nig) % gsz); u.pn = (wgid % nig) / gsz; return true;
    }
    __device__ __forceinline__ void a_ready(const Unit&) const {}
    __device__ __forceinline__ void done(const Unit&) const {}
};
__device__ __forceinline__ unsigned cvt_pk_bf16(float lo, float hi) { unsigned r; asm volatile("v_cvt_pk_bf16_f32 %0, %1, %2" : "=v"(r) : "v"(lo), "v"(hi)); return r; }
typedef float f32x2 __attribute__((ext_vector_type(2)));
template <class Epi, class Sched, bool ALIGN_EPI = false, bool SP2 = false>
__device__ __forceinline__ void gemm_phase(PG8_LAS unsigned char* lds, const Gemm g, const Sched& S, const Epi& E) {
    const int tid = threadIdx.x, wid = __builtin_amdgcn_readfirstlane(tid >> 6), lane = tid & 63, wr = wid >> 2, wc = wid & 3, fr = lane & 15, fq = lane >> 4;
    const int K = g.K, nt = K / BK;
    unsigned voffA[2], voffB[2];
#pragma unroll
    for (int i = 0; i < 2; ++i) { int R, C; stage_rc(tid * 16 + i * 8192, R, C); const int Rb = Epi::PERM ? ((R & ~31) + perm32(R & 31)) : R;
        voffA[i] = (unsigned)(R * K + C) * 2u; voffB[i] = (unsigned)(Rb * K + C) * 2u; }
    const size_t kstep = (size_t)(BK * 2);
    const size_t hstep = (size_t)HALF * K * 2;
    const size_t tstep = 2 * hstep;
    const unsigned ldsw = (unsigned)wid * 1024u;
    const int aoff = lds_byte(wr * 64 + fr, fq * 8), boff = lds_byte(wc * 32 + fr, fq * 8);
#define PG8_SA(b, h) (((b) * 2 + (h)) * HTB)
#define PG8_SB(b, h) ((4 + (b) * 2 + (h)) * HTB)
#define PG8_STAGE(bufoff, gbase, voff) do { _Pragma("unroll") for (int _i = 0; _i < 2; ++_i) \
        __builtin_amdgcn_global_load_lds((const unsigned*)((const char*)(gbase) + (voff)[_i]), (PG8_LAS unsigned*)(lds + (bufoff) + ldsw + _i * 8192), 16, 0, 0); } while (0)
#define PG8_LDA(dst, b, h) do { _Pragma("unroll") for (int m = 0; m < 4; ++m) _Pragma("unroll") for (int k = 0; k < 2; ++k) dst[m][k] = *(const PG8_LAS bf16x8*)(lds + PG8_SA(b, h) + aoff + m * 2048 + k * 1024); } while (0)
#define PG8_LDB(dst, b, h) do { _Pragma("unroll") for (int n = 0; n < 2; ++n) _Pragma("unroll") for (int k = 0; k < 2; ++k) dst[n][k] = *(const PG8_LAS bf16x8*)(lds + PG8_SB(b, h) + boff + n * 2048 + k * 1024); } while (0)
#define PG8_MMA(ai, bj, At, Bt) do { __builtin_amdgcn_s_setprio(1); _Pragma("unroll") for (int m = 0; m < 4; ++m) _Pragma("unroll") for (int n = 0; n < 2; ++n) _Pragma("unroll") for (int k = 0; k < 2; ++k) \
        acc[ai][bj][m][n] = __builtin_amdgcn_mfma_f32_16x16x32_bf16(Bt[n][k], At[m][k], acc[ai][bj][m][n], 0, 0, 0); __builtin_amdgcn_s_setprio(0); } while (0)
#define PG8_WAIT_V(n) asm volatile("s_waitcnt vmcnt(" #n ")" ::: "memory")
#define PG8_WAIT_L(n) asm volatile("s_waitcnt lgkmcnt(" #n ")" ::: "memory")
#define PG8_BAR __builtin_amdgcn_s_barrier()
#define PG8_SCHED __builtin_amdgcn_sched_barrier(0)
    Unit cur, nxt; int ui = 0;
    if (!S.next(0, cur)) return;
    f32x4 acc[2][2][4][2];
#pragma unroll
    for (int a = 0; a < 2; ++a)
#pragma unroll
        for (int b = 0; b < 2; ++b)
#pragma unroll
            for (int m = 0; m < 4; ++m)
#pragma unroll
                for (int n = 0; n < 2; ++n) acc[a][b][m][n] = (f32x4){0.f, 0.f, 0.f, 0.f};
    bf16x8 At[4][2], B0[2][2], B1[2][2];
    const char* cA = (const char*)g.A + (size_t)cur.pm * tstep; const char* cB = (const char*)g.Bt + (size_t)cur.pn * tstep;
    S.a_ready(cur);
    if constexpr (SP2) {
        PG8_STAGE(PG8_SB(0, 0), cB, voffB); PG8_STAGE(PG8_SB(0, 1), cB + hstep, voffB); PG8_STAGE(PG8_SA(0, 0), cA, voffA); PG8_STAGE(PG8_SA(0, 1), cA + hstep, voffA);
        if (wr == 1) PG8_BAR;
        PG8_WAIT_V(2); PG8_BAR;
        PG8_STAGE(PG8_SB(1, 0), cB + kstep, voffB); PG8_STAGE(PG8_SA(1, 0), cA + kstep, voffA); PG8_STAGE(PG8_SB(1, 1), cB + hstep + kstep, voffB);
        PG8_WAIT_V(6); PG8_BAR;
    } else {
        PG8_STAGE(PG8_SB(0, 0), cB, voffB); PG8_STAGE(PG8_SA(0, 0), cA, voffA); PG8_STAGE(PG8_SB(0, 1), cB + hstep, voffB); PG8_STAGE(PG8_SA(0, 1), cA + hstep, voffA);
        if (wr == 1) PG8_BAR;
        PG8_WAIT_V(4); PG8_BAR;
        PG8_STAGE(PG8_SB(1, 0), cB + kstep, voffB); PG8_STAGE(PG8_SA(1, 0), cA + kstep, voffA); PG8_STAGE(PG8_SB(1, 1), cB + hstep + kstep, voffB);
        PG8_WAIT_V(6); PG8_BAR;
    }
    for (;;) {
        const bool has_next = S.next(ui + 1, nxt);
        const char* nA = has_next ? (const char*)g.A + (size_t)nxt.pm * tstep : cA; const char* nB = has_next ? (const char*)g.Bt + (size_t)nxt.pn * tstep : cB;
        for (int t = 0; t < nt; t += 2) {
            const bool last = (t == nt - 2);
            const char* a1 = cA + (size_t)(t + 1) * kstep;
            const char* a2 = last ? nA : cA + (size_t)(t + 2) * kstep; const char* b2 = last ? nB : cB + (size_t)(t + 2) * kstep;
            const char* a3 = a2 + kstep; const char* b3 = b2 + kstep;
            if (last && has_next) S.a_ready(nxt);
            if constexpr (SP2) {
            PG8_LDB(B0, 0, 0); PG8_LDB(B1, 0, 1); PG8_SCHED; PG8_LDA(At, 0, 0); PG8_STAGE(PG8_SA(1, 1), a1 + hstep, voffA);
            PG8_WAIT_V(8); PG8_WAIT_L(0); PG8_BAR; PG8_MMA(0, 0, At, B0); PG8_MMA(0, 1, At, B1); PG8_BAR; PG8_SCHED;
            PG8_LDA(At, 0, 1); PG8_STAGE(PG8_SB(0, 0), b2, voffB); PG8_STAGE(PG8_SB(0, 1), b2 + hstep, voffB); PG8_STAGE(PG8_SA(0, 0), a2, voffA);
            PG8_WAIT_V(8); PG8_WAIT_L(0); PG8_BAR; PG8_MMA(1, 0, At, B0); PG8_MMA(1, 1, At, B1); PG8_BAR; PG8_SCHED;
            PG8_LDB(B0, 1, 0); PG8_LDB(B1, 1, 1); PG8_SCHED; PG8_LDA(At, 1, 0); PG8_STAGE(PG8_SA(0, 1), a2 + hstep, voffA);
            PG8_WAIT_V(8); PG8_WAIT_L(0); PG8_BAR; PG8_MMA(0, 0, At, B0); PG8_MMA(0, 1, At, B1); PG8_BAR; PG8_SCHED;
            PG8_LDA(At, 1, 1); PG8_STAGE(PG8_SB(1, 0), b3, voffB); PG8_STAGE(PG8_SB(1, 1), b3 + hstep, voffB); PG8_STAGE(PG8_SA(1, 0), a3, voffA);
            PG8_WAIT_V(8); PG8_WAIT_L(0); PG8_BAR; PG8_MMA(1, 0, At, B0); PG8_MMA(1, 1, At, B1); PG8_BAR; PG8_SCHED;
            } else {
            PG8_LDB(B0, 0, 0); PG8_SCHED; PG8_LDA(At, 0, 0); PG8_STAGE(PG8_SA(1, 1), a1 + hstep, voffA);
            PG8_WAIT_L(8); PG8_BAR; PG8_WAIT_L(0); PG8_MMA(0, 0, At, B0); PG8_BAR; PG8_SCHED;
            PG8_LDB(B1, 0, 1); PG8_STAGE(PG8_SB(0, 0), b2, voffB);
            PG8_BAR; PG8_WAIT_L(0); PG8_MMA(0, 1, At, B1); PG8_BAR;
            PG8_LDA(At, 0, 1); PG8_STAGE(PG8_SA(0, 0), a2, voffA);
            PG8_BAR; PG8_WAIT_L(0); PG8_MMA(1, 0, At, B0); PG8_BAR; PG8_SCHED;
            PG8_STAGE(PG8_SB(0, 1), b2 + hstep, voffB);
            PG8_WAIT_V(6); PG8_BAR; PG8_MMA(1, 1, At, B1); PG8_BAR;
            PG8_LDB(B0, 1, 0); PG8_SCHED; PG8_LDA(At, 1, 0); PG8_STAGE(PG8_SA(0, 1), a2 + hstep, voffA);
            PG8_WAIT_L(8); PG8_BAR; PG8_WAIT_L(0); PG8_MMA(0, 0, At, B0); PG8_BAR; PG8_SCHED;
            PG8_LDB(B1, 1, 1); PG8_STAGE(PG8_SB(1, 0), b3, voffB);
            PG8_BAR; PG8_WAIT_L(0); PG8_MMA(0, 1, At, B1); PG8_BAR;
            PG8_LDA(At, 1, 1); PG8_STAGE(PG8_SA(1, 0), a3, voffA);
            PG8_BAR; PG8_WAIT_L(0); PG8_MMA(1, 0, At, B0); PG8_BAR; PG8_SCHED;
            PG8_STAGE(PG8_SB(1, 1), b3 + hstep, voffB);
            PG8_WAIT_V(6); PG8_BAR; PG8_MMA(1, 1, At, B1); PG8_BAR;
            }
        }
        if constexpr (ALIGN_EPI) { if (wr == 0) PG8_BAR; }
        if constexpr (!Epi::AFTER_DRAIN) { E(acc, cur, wr, wc, fr, fq); S.done(cur); }
        if (!has_next) break;
#pragma unroll
        for (int a = 0; a < 2; ++a)
#pragma unroll
            for (int b = 0; b < 2; ++b)
#pragma unroll
                for (int m = 0; m < 4; ++m)
#pragma unroll
                    for (int n = 0; n < 2; ++n) acc[a][b][m][n] = (f32x4){0.f, 0.f, 0.f, 0.f};
        cur = nxt; cA = nA; cB = nB; ++ui;
        if constexpr (ALIGN_EPI) { if (wr == 1) PG8_BAR; }
    }
    PG8_WAIT_V(0);
    if constexpr (!ALIGN_EPI) { if (wr == 0) PG8_BAR; }
    PG8_BAR;
    if constexpr (Epi::AFTER_DRAIN) { E.fused(acc, cur, wr, wc, fr, fq, lds, wid, lane); S.done(cur); }
#undef PG8_SA
#undef PG8_SB
#undef PG8_STAGE
#undef PG8_LDA
#undef PG8_LDB
#undef PG8_MMA
#undef PG8_WAIT_V
#undef PG8_WAIT_L
#undef PG8_BAR
#undef PG8_SCHED
}
}
#define GAS __attribute__((address_space(1)))
#define LAS __attribute__((address_space(3)))
typedef unsigned short bf16;
typedef unsigned v4u __attribute__((ext_vector_type(4)));
typedef float f32x4 __attribute__((ext_vector_type(4)));
typedef short bf16x8 __attribute__((ext_vector_type(8)));
typedef GAS unsigned gu32;
typedef GAS unsigned long long gu64;
#define RLX_AGENT __ATOMIC_RELAXED, __HIP_MEMORY_SCOPE_AGENT
#define LDS_WAIT() asm volatile("s_waitcnt lgkmcnt(0)" ::: "memory")
#define VM_WAIT() asm volatile("s_waitcnt vmcnt(0)" ::: "memory")
__device__ __forceinline__ unsigned long long rt() { return __builtin_amdgcn_s_memrealtime(); }
__device__ __forceinline__ unsigned f2bf(float f) { unsigned u = __builtin_bit_cast(unsigned, f); return (u + 0x7fffu + ((u >> 16) & 1u)) >> 16; }
__device__ __forceinline__ unsigned pk2(float lo, float hi) { return f2bf(lo) | (f2bf(hi) << 16); }
#define XB_TMO      128
#define XB_XCNT(j)  (256  + 64 * (j))
#define XB_XSUB(j)  (1280 + 64 * (j))
#define XB_XGEN(j)  (2304 + 64 * (j))
#define XB_TOP      3328
#define XB_TOPGEN   3392
#define XCD_BAR_WORDS 3456
#define XB_SPIN_CAP (1u << 22)

__device__ __forceinline__ unsigned xb_ld(unsigned* p)              { return __hip_atomic_load(p, __ATOMIC_RELAXED, __HIP_MEMORY_SCOPE_AGENT); }
__device__ __forceinline__ unsigned xb_add(unsigned* p, unsigned v) { return __hip_atomic_fetch_add(p, v, __ATOMIC_RELAXED, __HIP_MEMORY_SCOPE_AGENT); }
__device__ __forceinline__ unsigned xb_xcc_id() { return (unsigned)__builtin_amdgcn_s_getreg((3 << 11) | 20) & 0xFu; }
#define XB_SPIN(cond, bar) do { unsigned _sp = 0; while (cond) { __builtin_amdgcn_s_sleep(1); \
    if ((++_sp & 255u) == 0u) { if (xb_ld(&(bar)[XB_TMO])) break; if (_sp > XB_SPIN_CAP) { atomicAdd(&(bar)[XB_TMO], 1u); break; } } } } while (0)

struct XcdBarrier {
    unsigned* bar; unsigned x;
    volatile LAS unsigned* st;
};

__device__ __forceinline__ XcdBarrier xcd_barrier_post(unsigned* bar, volatile LAS unsigned* st) {
    XcdBarrier b; b.bar = bar; b.x = xb_xcc_id(); b.st = st;
    if (threadIdx.x == 0) (void)xb_add(&bar[XB_XCNT(b.x)], 1u);
    return b;
}
__device__ __forceinline__ void xcd_barrier_complete(unsigned* bar, unsigned x, unsigned& nloc, unsigned& nx) {
    const unsigned G = gridDim.x * gridDim.y * gridDim.z;
    unsigned sum, cnt, mine, sp = 0u;
    for (;;) {
        sum = 0u; cnt = 0u; mine = 0u;
#pragma unroll
        for (unsigned j = 0; j < 16; ++j) { const unsigned c = xb_ld(&bar[XB_XCNT(j)]); sum += c; cnt += (c > 0u) ? 1u : 0u; mine = (j == x) ? c : mine; }
        if (sum == G) break;
        __builtin_amdgcn_s_sleep(1);
        if ((++sp & 255u) == 0u) { if (xb_ld(&bar[XB_TMO])) break; if (sp > XB_SPIN_CAP) { atomicAdd(&bar[XB_TMO], 1u); break; } }
    }
    nloc = mine > 0u ? mine : 1u; nx = cnt > 0u ? cnt : 1u;
}

__device__ __forceinline__ void xcd_barrier(const XcdBarrier& b) {
    asm volatile("s_waitcnt vmcnt(0)" ::: "memory");
    __syncthreads();
    if (threadIdx.x == 0) {
        unsigned* bar = b.bar;
        __builtin_amdgcn_s_waitcnt(0);
        unsigned nloc = b.st[0], nx = b.st[1];
        if (nloc == 0u) { xcd_barrier_complete(bar, b.x, nloc, nx); b.st[0] = nloc; b.st[1] = nx; }
        const unsigned old = xb_add(&bar[XB_XSUB(b.x)], 1u);
        const unsigned gen = old / nloc;
        if (old + 1u == (gen + 1u) * nloc) {
            __builtin_amdgcn_fence(__ATOMIC_RELEASE, "agent");
            asm volatile("s_waitcnt vmcnt(0)" ::: "memory");
            const unsigned og = xb_add(&bar[XB_TOP], 1u);
            const unsigned tg = og / nx;
            if (og + 1u == (tg + 1u) * nx) xb_add(&bar[XB_TOPGEN], 1u);
            else XB_SPIN(xb_ld(&bar[XB_TOPGEN]) == tg, bar);
            __builtin_amdgcn_fence(__ATOMIC_ACQUIRE, "agent");
            xb_add(&bar[XB_XGEN(b.x)], 1u);
            asm volatile("s_waitcnt vmcnt(0)" ::: "memory");
        } else {
            XB_SPIN(xb_ld(&bar[XB_XGEN(b.x)]) == gen, bar);
            __builtin_amdgcn_fence(__ATOMIC_ACQUIRE, "agent");
            asm volatile("s_waitcnt vmcnt(0)" ::: "memory");
        }
    }
    __syncthreads();
}
__device__ __forceinline__ float wave_sum(float v) {
#pragma unroll
    for (int o = 1; o < 64; o <<= 1) v += __shfl_xor(v, o);
    return v;
}

typedef unsigned short u16;
typedef float f32x2_t __attribute__((ext_vector_type(2)));
constexpr int NWAVES = 8;
constexpr int DM = 4096, T0 = 8192, T1 = 16384, M = T0 + T1;
constexpr int HGW = 2048, AW = 2048, KVW = 512, INW = 21504, DFF = 11008;
constexpr float EPS = 1e-6f;
constexpr size_t MiB = 1u << 20;
constexpr size_t WS_CTL = 0, CTL_ZERO_BYTES = 65536;
constexpr size_t WS_WA = 1 * MiB, WS_WB = 17 * MiB, WS_WOUT = 33 * MiB, WS_WGU = 65 * MiB, WS_WDN = 237 * MiB;
constexpr size_t WS_HQ = 323 * MiB, WS_ZF = 419 * MiB, WS_ZB = 515 * MiB, WS_HI = 611 * MiB, WS_HOG = 707 * MiB, WS_AQ = 803 * MiB;
constexpr size_t WS_AK = 899 * MiB, WS_AV = 923 * MiB, WS_GA = 947 * MiB, WS_GB = 1139 * MiB, WS_END = 1331 * MiB;
constexpr size_t WS_T = WS_ZF, WS_MERGED = WS_HI, WS_XN2 = WS_GA, WS_ACT = WS_HQ, WS_X1B = WS_GB, WS_X2B = WS_GA;
constexpr size_t DO_WIN = 0, DO_H = 168 * MiB, DO_OF = 0, DO_OB = 192 * MiB;
static_assert(WS_ACT + (size_t)M * DFF * 2 <= WS_AK && DO_H + (size_t)M * DM * 2 <= (size_t)M * DM * 4, "maps");
constexpr int CW_BAR = 4096;
constexpr int LDS_BYTES = 147456;
constexpr int MISC_OFF = 131072 + 320;

typedef _Float16 f16x2_t __attribute__((ext_vector_type(2)));
typedef _Float16 f16x8_t __attribute__((ext_vector_type(8)));
typedef unsigned u32x2_t __attribute__((ext_vector_type(2)));
typedef __bf16 bf16x2_t __attribute__((ext_vector_type(2)));
__device__ __forceinline__ unsigned pkbf(float lo, float hi) { f32x2_t v = {lo, hi}; bf16x2_t b = __builtin_convertvector(v, bf16x2_t); return __builtin_bit_cast(unsigned, b); }
__device__ __forceinline__ unsigned pkh(float lo, float hi) { f32x2_t v = {lo, hi}; f16x2_t h = __builtin_convertvector(v, f16x2_t); return __builtin_bit_cast(unsigned, h); }
__device__ __forceinline__ float bflo(unsigned w) { return __uint_as_float(w << 16); }
__device__ __forceinline__ float bfhi(unsigned w) { return __uint_as_float(w & 0xffff0000u); }
__device__ __forceinline__ float bf1(u16 h) { return __uint_as_float(((unsigned)h) << 16); }
__device__ __forceinline__ float sigm(float x) { return __builtin_amdgcn_rcpf(1.0f + __expf(-x)); }

template <int OP>
__device__ __forceinline__ void epi_store16(const pg8::f32x4 (&acc)[2][2][4][2], u16* base, int ldc, int row0, int col0) {
#pragma unroll
    for (int ai = 0; ai < 2; ++ai)
#pragma unroll
        for (int m = 0; m < 4; ++m) { u16* rowp = base + (size_t)(row0 + ai * 128 + m * 16) * ldc + col0;
#pragma unroll
            for (int bj = 0; bj < 2; ++bj) { pg8::f32x4 v0 = acc[ai][bj][m][0], v1 = acc[ai][bj][m][1];
                if (OP == 2) {
#pragma unroll
                    for (int e = 0; e < 4; ++e) { v0[e] = v0[e] * sigm(v0[e]); v1[e] = v1[e] * sigm(v1[e]); } }
                if (OP == 3) {
#pragma unroll
                    for (int e = 0; e < 4; ++e) { v0[e] = sigm(v0[e]); v1[e] = sigm(v1[e]); } }
                pg8::u32x4 w;
                if (OP == 1) { w.x = pkh(v0[0], v0[1]); w.y = pkh(v0[2], v0[3]); w.z = pkh(v1[0], v1[1]); w.w = pkh(v1[2], v1[3]); }
                else { w.x = pkbf(v0[0], v0[1]); w.y = pkbf(v0[2], v0[3]); w.z = pkbf(v1[0], v1[1]); w.w = pkbf(v1[2], v1[3]); }
                *(pg8::u32x4*)(rowp + bj * 128) = w; } }
}
struct EpiInProj {
    static constexpr bool PERM = true, AFTER_DRAIN = false;
    unsigned char* ws;
    __device__ __forceinline__ void operator()(const pg8::f32x4 (&acc)[2][2][4][2], const pg8::Unit& u, int wr, int wc, int fr, int fq) const {
        const int pn = u.pn, row0 = u.pm * 256 + wr * 64 + fr, cw = wc * 32 + 8 * fq;
        if (pn < 8)       epi_store16<0>(acc, (u16*)(ws + WS_HQ), HGW, row0, (pn - 0) * 256 + cw);
        else if (pn < 16) epi_store16<1>(acc, (u16*)(ws + WS_ZF), HGW, row0, (pn - 8) * 256 + cw);
        else if (pn < 24) epi_store16<1>(acc, (u16*)(ws + WS_ZB), HGW, row0, (pn - 16) * 256 + cw);
        else if (pn < 32) epi_store16<0>(acc, (u16*)(ws + WS_HI), HGW, row0, (pn - 24) * 256 + cw);
        else if (pn < 40) epi_store16<2>(acc, (u16*)(ws + WS_HOG), HGW, row0, (pn - 32) * 256 + cw);
        else if (pn < 48) epi_store16<0>(acc, (u16*)(ws + WS_AQ), AW, row0, (pn - 40) * 256 + cw);
        else if (pn < 50) epi_store16<0>(acc, (u16*)(ws + WS_AK), KVW, row0, (pn - 48) * 256 + cw);
        else if (pn < 52) epi_store16<0>(acc, (u16*)(ws + WS_AV), KVW, row0, (pn - 50) * 256 + cw);
        else if (pn < 68) epi_store16<3>(acc, (u16*)(ws + WS_GA), DM, row0, (pn - 52) * 256 + cw);
        else              epi_store16<3>(acc, (u16*)(ws + WS_GB), DM, row0, (pn - 68) * 256 + cw);
    }
};
template <bool ADD> struct EpiGate {
    static constexpr bool PERM = true, AFTER_DRAIN = false;
    const u16* sg; const u16* tin; u16* out;
    __device__ __forceinline__ void operator()(const pg8::f32x4 (&acc)[2][2][4][2], const pg8::Unit& u, int wr, int wc, int fr, int fq) const {
        const int row0 = u.pm * 256 + wr * 64 + fr, col0 = u.pn * 256 + wc * 32 + 8 * fq;
#pragma unroll
        for (int ai = 0; ai < 2; ++ai)
#pragma unroll
            for (int mp = 0; mp < 2; ++mp) {
                pg8::u32x4 g[2][2], t[2][2];
#pragma unroll
                for (int mm = 0; mm < 2; ++mm)
#pragma unroll
                    for (int bj = 0; bj < 2; ++bj) { const size_t off = (size_t)(row0 + ai * 128 + (2 * mp + mm) * 16) * DM + col0 + bj * 128;
                        g[mm][bj] = *(const pg8::u32x4*)(sg + off); if (ADD) t[mm][bj] = *(const pg8::u32x4*)(tin + off); }
                __builtin_amdgcn_sched_barrier(0);
#pragma unroll
                for (int mm = 0; mm < 2; ++mm)
#pragma unroll
                    for (int bj = 0; bj < 2; ++bj) { const int m = 2 * mp + mm; const size_t off = (size_t)(row0 + ai * 128 + m * 16) * DM + col0 + bj * 128;
                        const pg8::f32x4 v0 = acc[ai][bj][m][0], v1 = acc[ai][bj][m][1]; const pg8::u32x4 gg = g[mm][bj];
                        float r[8] = {bflo(gg.x) * v0[0], bfhi(gg.x) * v0[1], bflo(gg.y) * v0[2], bfhi(gg.y) * v0[3], bflo(gg.z) * v1[0], bfhi(gg.z) * v1[1], bflo(gg.w) * v1[2], bfhi(gg.w) * v1[3]};
                        if (ADD) { const pg8::u32x4 tt = t[mm][bj];
                            r[0] += bflo(tt.x); r[1] += bfhi(tt.x); r[2] += bflo(tt.y); r[3] += bfhi(tt.y); r[4] += bflo(tt.z); r[5] += bfhi(tt.z); r[6] += bflo(tt.w); r[7] += bfhi(tt.w); }
                        pg8::u32x4 w; w.x = pkbf(r[0], r[1]); w.y = pkbf(r[2], r[3]); w.z = pkbf(r[4], r[5]); w.w = pkbf(r[6], r[7]);
                        *(pg8::u32x4*)(out + off) = w; }
                __builtin_amdgcn_sched_barrier(0);
            }
    }
};
struct EpiResF32 {
    static constexpr bool PERM = true, AFTER_DRAIN = false;
    const float* base0; const float* base1; float* out;
    __device__ __forceinline__ void operator()(const pg8::f32x4 (&acc)[2][2][4][2], const pg8::Unit& u, int wr, int wc, int fr, int fq) const {
        const int col0 = u.pn * 256 + wc * 32 + 8 * fq;
        const int r0t = u.pm * 256;
        const float* bt = (r0t < T0) ? base0 + (size_t)r0t * DM : base1 + (size_t)(r0t - T0) * DM; float* ot = out + (size_t)r0t * DM;
#pragma unroll
        for (int ai = 0; ai < 2; ++ai)
#pragma unroll
            for (int mp = 0; mp < 2; ++mp) {
                pg8::f32x4 b[2][2][2];
#pragma unroll
                for (int mm = 0; mm < 2; ++mm)
#pragma unroll
                    for (int bj = 0; bj < 2; ++bj) { const float* bs = bt + (size_t)(ai * 128 + wr * 64 + (2 * mp + mm) * 16 + fr) * DM + col0 + bj * 128;
                        b[mm][bj][0] = *(const pg8::f32x4*)bs; b[mm][bj][1] = *(const pg8::f32x4*)(bs + 4); }
                __builtin_amdgcn_sched_barrier(0);
#pragma unroll
                for (int mm = 0; mm < 2; ++mm)
#pragma unroll
                    for (int bj = 0; bj < 2; ++bj) { const int m = 2 * mp + mm; float* op = ot + (size_t)(ai * 128 + wr * 64 + m * 16 + fr) * DM + col0 + bj * 128;
                        *(pg8::f32x4*)op = b[mm][bj][0] + acc[ai][bj][m][0]; *(pg8::f32x4*)(op + 4) = b[mm][bj][1] + acc[ai][bj][m][1]; }
                __builtin_amdgcn_sched_barrier(0);
            }
    }
};
struct EpiResToB16 {
    static constexpr bool PERM = true, AFTER_DRAIN = false;
    const float* base0; const float* base1; u16* out;
    __device__ __forceinline__ void operator()(const pg8::f32x4 (&acc)[2][2][4][2], const pg8::Unit& u, int wr, int wc, int fr, int fq) const {
        const int col0 = u.pn * 256 + wc * 32 + 8 * fq;
        const int r0t = u.pm * 256;
        const float* bt = (r0t < T0) ? base0 + (size_t)r0t * DM : base1 + (size_t)(r0t - T0) * DM; u16* ot = out + (size_t)r0t * DM;
#pragma unroll
        for (int ai = 0; ai < 2; ++ai)
#pragma unroll
            for (int mp = 0; mp < 2; ++mp) {
                pg8::f32x4 b[2][2][2];
#pragma unroll
                for (int mm = 0; mm < 2; ++mm)
#pragma unroll
                    for (int bj = 0; bj < 2; ++bj) { const float* bs = bt + (size_t)(ai * 128 + wr * 64 + (2 * mp + mm) * 16 + fr) * DM + col0 + bj * 128;
                        b[mm][bj][0] = *(const pg8::f32x4*)bs; b[mm][bj][1] = *(const pg8::f32x4*)(bs + 4); }
                __builtin_amdgcn_sched_barrier(0);
#pragma unroll
                for (int mm = 0; mm < 2; ++mm)
#pragma unroll
                    for (int bj = 0; bj < 2; ++bj) { const int m = 2 * mp + mm; u16* op = ot + (size_t)(ai * 128 + wr * 64 + m * 16 + fr) * DM + col0 + bj * 128;
                        const pg8::f32x4 v0 = b[mm][bj][0] + acc[ai][bj][m][0], v1 = b[mm][bj][1] + acc[ai][bj][m][1];
                        pg8::u32x4 w; w.x = pkbf(v0[0], v0[1]); w.y = pkbf(v0[2], v0[3]); w.z = pkbf(v1[0], v1[1]); w.w = pkbf(v1[2], v1[3]);
                        *(pg8::u32x4*)op = w; }
                __builtin_amdgcn_sched_barrier(0);
            }
    }
};
struct EpiResFromB16 {
    static constexpr bool PERM = true, AFTER_DRAIN = false;
    const u16* res; float* out;
    __device__ __forceinline__ void operator()(const pg8::f32x4 (&acc)[2][2][4][2], const pg8::Unit& u, int wr, int wc, int fr, int fq) const {
        const size_t o0 = (size_t)(u.pm * 256 + wr * 64 + fr) * DM + u.pn * 256 + wc * 32 + 8 * fq;
#pragma unroll
        for (int ai = 0; ai < 2; ++ai) {
            pg8::u32x4 b[4][2];
#pragma unroll
            for (int m = 0; m < 4; ++m)
#pragma unroll
                for (int bj = 0; bj < 2; ++bj) b[m][bj] = *(const pg8::u32x4*)(res + o0 + (size_t)(ai * 128 + m * 16) * DM + bj * 128);
            __builtin_amdgcn_sched_barrier(0);
#pragma unroll
            for (int m = 0; m < 4; ++m)
#pragma unroll
                for (int bj = 0; bj < 2; ++bj) { float* op = out + o0 + (size_t)(ai * 128 + m * 16) * DM + bj * 128; const pg8::u32x4 g = b[m][bj];
                    const pg8::f32x4 r0 = {bflo(g.x), bfhi(g.x), bflo(g.y), bfhi(g.y)}, r1 = {bflo(g.z), bfhi(g.z), bflo(g.w), bfhi(g.w)};
                    *(pg8::f32x4*)op = r0 + acc[ai][bj][m][0]; *(pg8::f32x4*)(op + 4) = r1 + acc[ai][bj][m][1]; }
            __builtin_amdgcn_sched_barrier(0);
        }
    }
};
struct EpiPlainB16 {
    static constexpr bool PERM = true, AFTER_DRAIN = false;
    u16* out;
    __device__ __forceinline__ void operator()(const pg8::f32x4 (&acc)[2][2][4][2], const pg8::Unit& u, int wr, int wc, int fr, int fq) const {
        epi_store16<0>(acc, out, DM, u.pm * 256 + wr * 64 + fr, u.pn * 256 + wc * 32 + 8 * fq);
    }
};
struct EpiResB16 {
    static constexpr bool PERM = true, AFTER_DRAIN = false;
    const u16* res; u16* out;
    __device__ __forceinline__ void operator()(const pg8::f32x4 (&acc)[2][2][4][2], const pg8::Unit& u, int wr, int wc, int fr, int fq) const {
        const size_t o0 = (size_t)(u.pm * 256 + wr * 64 + fr) * DM + u.pn * 256 + wc * 32 + 8 * fq;
#pragma unroll
        for (int ai = 0; ai < 2; ++ai) {
            pg8::u32x4 b[4][2];
#pragma unroll
            for (int m = 0; m < 4; ++m)
#pragma unroll
                for (int bj = 0; bj < 2; ++bj) b[m][bj] = *(const pg8::u32x4*)(res + o0 + (size_t)(ai * 128 + m * 16) * DM + bj * 128);
            __builtin_amdgcn_sched_barrier(0);
#pragma unroll
            for (int m = 0; m < 4; ++m)
#pragma unroll
                for (int bj = 0; bj < 2; ++bj) { const pg8::u32x4 g = b[m][bj]; const pg8::f32x4 v0 = acc[ai][bj][m][0], v1 = acc[ai][bj][m][1];
                    pg8::u32x4 w; w.x = pkbf(bflo(g.x) + v0[0], bfhi(g.x) + v0[1]); w.y = pkbf(bflo(g.y) + v0[2], bfhi(g.y) + v0[3]); w.z = pkbf(bflo(g.z) + v1[0], bfhi(g.z) + v1[1]); w.w = pkbf(bflo(g.w) + v1[2], bfhi(g.w) + v1[3]);
                    *(pg8::u32x4*)(out + o0 + (size_t)(ai * 128 + m * 16) * DM + bj * 128) = w; }
            __builtin_amdgcn_sched_barrier(0);
        }
    }
};
struct EpiSwiGLU {
    static constexpr bool PERM = true, AFTER_DRAIN = false;
    u16* out;
    __device__ __forceinline__ void operator()(const pg8::f32x4 (&acc)[2][2][4][2], const pg8::Unit& u, int wr, int wc, int fr, int fq) const {
        const int row0 = u.pm * 256 + wr * 64 + fr, col0 = u.pn * 128 + wc * 32 + 8 * fq;
#pragma unroll
        for (int ai = 0; ai < 2; ++ai)
#pragma unroll
            for (int m = 0; m < 4; ++m) { const pg8::f32x4 g0 = acc[ai][0][m][0], g1 = acc[ai][0][m][1], u0 = acc[ai][1][m][0], u1 = acc[ai][1][m][1];
                float r[8];
#pragma unroll
                for (int e = 0; e < 4; ++e) { r[e] = g0[e] * sigm(g0[e]) * u0[e]; r[4 + e] = g1[e] * sigm(g1[e]) * u1[e]; }
                pg8::u32x4 w; w.x = pkbf(r[0], r[1]); w.y = pkbf(r[2], r[3]); w.z = pkbf(r[4], r[5]); w.w = pkbf(r[6], r[7]);
                *(pg8::u32x4*)(out + (size_t)(row0 + ai * 128 + m * 16) * DFF + col0) = w; }
    }
};


namespace att {
using bf16x8 = __attribute__((ext_vector_type(8))) short;
using s16x4  = __attribute__((ext_vector_type(4))) short;
using f32x16 = __attribute__((ext_vector_type(16))) float;
using u32x4  = __attribute__((ext_vector_type(4))) unsigned;
using f32x4  = __attribute__((ext_vector_type(4))) float;
constexpr int   D = 128, NW = 8, QBLK = 32, KVBLK = 64, LDQ = 2048, LDK = 512;
constexpr float SCALE = 0.088388347648318440f;
constexpr size_t SHM_V = KVBLK * D * 2, SHM_K = KVBLK * D * 2, RING = 4, WS_OFF = 132096;
#define KSWZ(row, colB) ((row) * 256 + ((colB) ^ (((row) & 15) << 4)))
#define SBAR() __builtin_amdgcn_sched_barrier(0)
__device__ __forceinline__ int crow(int r, int hi) { return (r & 3) + 8 * (r >> 2) + 4 * hi; }
__device__ __forceinline__ unsigned cvtpk(float lo, float hi) { return pkbf(lo, hi); }
template <bool SHIFT> __device__ __forceinline__ void partialSM(f32x16& p0, f32x16& p1, float negBl2) {
  constexpr float C = SCALE * 1.4426950408889634f;
  if constexpr (SHIFT) {
    for (int r = 0; r < 16; ++r) { float t = fmaf(p0[r], C, negBl2); asm("" : "+v"(t)); p0[r] = t; } for (int r = 0; r < 16; ++r) { float t = fmaf(p1[r], C, negBl2); asm("" : "+v"(t)); p1[r] = t; } }
  for (int r = 0; r < 16; ++r) p0[r] = __builtin_amdgcn_exp2f(p0[r]);
}
__device__ __forceinline__ void qkt(f32x16& p0, f32x16& p1, const u16* Ks, const bf16x8* qr, int r32, int hi) {
  p0 = f32x16{}; p1 = f32x16{};
  const char* k0p = (const char*)Ks + r32 * 256; const char* k1p = k0p + 32 * 256; const int sw = (r32 & 15) << 4, hb = hi * 16;
#define QK_RD(d0, A, B) do { const int cb_ = ((d0) * 32 + hb) ^ sw; A = *reinterpret_cast<const bf16x8*>(k0p + cb_); B = *reinterpret_cast<const bf16x8*>(k1p + cb_); } while (0)
  bf16x8 a0, b0, a1, b1, c0, d0_, c1, d1;
  QK_RD(0, a0, b0); QK_RD(1, a1, b1);
#pragma unroll
  for (int g = 0; g < 4; ++g) {
    if (g < 3) { QK_RD(2 * g + 2, c0, d0_); QK_RD(2 * g + 3, c1, d1); }
    SBAR();
    p0 = __builtin_amdgcn_mfma_f32_32x32x16_bf16(a0, qr[2 * g], p0, 0, 0, 0); p1 = __builtin_amdgcn_mfma_f32_32x32x16_bf16(b0, qr[2 * g], p1, 0, 0, 0);
    p0 = __builtin_amdgcn_mfma_f32_32x32x16_bf16(a1, qr[2 * g + 1], p0, 0, 0, 0); p1 = __builtin_amdgcn_mfma_f32_32x32x16_bf16(b1, qr[2 * g + 1], p1, 0, 0, 0);
    SBAR();
    a0 = c0; b0 = d0_; a1 = c1; b1 = d1;
  }
#undef QK_RD
}
__device__ __forceinline__ int v_st(int k, int c) { const int kk = (k & ~0xC) | ((k & 4) << 1) | ((k & 8) >> 1); return ((kk >> 3) * 4 + (c >> 5)) * 512 + ((kk & 7) * 32 + (c & 31)) * 2; }
__device__ __forceinline__ int v_rd_base(int lane) { return ((lane & 3) << 3) | (((lane >> 2) & 3) << 6) | (((lane >> 4) & 1) << 5) | (((lane >> 5) & 1) << 8); }
constexpr int v_rd_off(int d0, int ks, int half) { return d0 * 512 + ks * 4096 + half * 2048; }
template <int OFF> __device__ __forceinline__ s16x4 tr_read(int vb) {
  s16x4 r; asm volatile("ds_read_b64_tr_b16 %0, %1 offset:%2" : "=&v"(r) : "v"(vb), "i"(OFF) : "memory"); return r;
}
template <int D0> __device__ __forceinline__ void pv_one(f32x16& od, int vb, bf16x8 pa0, bf16x8 pa1, bf16x8 pa2, bf16x8 pa3) {
  const s16x4 l0 = tr_read<v_rd_off(D0, 0, 0)>(vb), h0 = tr_read<v_rd_off(D0, 0, 1)>(vb), l1 = tr_read<v_rd_off(D0, 1, 0)>(vb), h1 = tr_read<v_rd_off(D0, 1, 1)>(vb);
  const s16x4 l2 = tr_read<v_rd_off(D0, 2, 0)>(vb), h2 = tr_read<v_rd_off(D0, 2, 1)>(vb), l3 = tr_read<v_rd_off(D0, 3, 0)>(vb), h3 = tr_read<v_rd_off(D0, 3, 1)>(vb);
  asm volatile("s_waitcnt lgkmcnt(0)" ::: "memory"); SBAR();
#define PK(L, H) (bf16x8){L[0], L[1], L[2], L[3], H[0], H[1], H[2], H[3]}
  od = __builtin_amdgcn_mfma_f32_32x32x16_bf16(pa0, PK(l0, h0), od, 0, 0, 0);
  od = __builtin_amdgcn_mfma_f32_32x32x16_bf16(pa1, PK(l1, h1), od, 0, 0, 0);
  od = __builtin_amdgcn_mfma_f32_32x32x16_bf16(pa2, PK(l2, h2), od, 0, 0, 0);
  od = __builtin_amdgcn_mfma_f32_32x32x16_bf16(pa3, PK(l3, h3), od, 0, 0, 0);
#undef PK
}
__device__ __forceinline__ void pv_d0(f32x16* o, int vb, bf16x8 pa0, bf16x8 pa1, bf16x8 pa2, bf16x8 pa3) {
  pv_one<0>(o[0], vb, pa0, pa1, pa2, pa3); pv_one<1>(o[1], vb, pa0, pa1, pa2, pa3); pv_one<2>(o[2], vb, pa0, pa1, pa2, pa3); pv_one<3>(o[3], vb, pa0, pa1, pa2, pa3);
}
#define PIN(x) asm volatile("" : "+v"(x))
#define MF32(a, b, c) __builtin_amdgcn_mfma_f32_32x32x16_bf16(a, b, c, 0, 0, 0)
struct VFrag { s16x4 l0, h0, l1, h1, l2, h2, l3, h3; };
#define VF_RD2(F, D0, KS, vb) do { F.l##KS = tr_read<v_rd_off(D0, KS, 0)>(vb); F.h##KS = tr_read<v_rd_off(D0, KS, 1)>(vb); } while (0)
#define VF_PK(F, KS) (bf16x8){F.l##KS[0], F.l##KS[1], F.l##KS[2], F.l##KS[3], F.h##KS[0], F.h##KS[1], F.h##KS[2], F.h##KS[3]}
#define PK4F(P, BASE, OUT) do { u32x4 w_ = {cvtpk(P[BASE + 0], P[BASE + 1]), cvtpk(P[BASE + 2], P[BASE + 3]), cvtpk(P[BASE + 4], P[BASE + 5]), cvtpk(P[BASE + 6], P[BASE + 7])}; \
    OUT = *reinterpret_cast<bf16x8*>(&w_); } while (0)
#define VF_RDF(F, D0, KS, vb) do { F.l##D0 = tr_read<v_rd_off(D0, KS, 0)>(vb); F.h##D0 = tr_read<v_rd_off(D0, KS, 1)>(vb); } while (0)
#define VF_PKF(F, D0) (bf16x8){F.l##D0[0], F.l##D0[1], F.l##D0[2], F.l##D0[3], F.h##D0[0], F.h##D0[1], F.h##D0[2], F.h##D0[3]}
#define BC8(w) __builtin_bit_cast(bf16x8, w)
template <int OFF> __device__ __forceinline__ bf16x8 kread(int a) { bf16x8 r; asm volatile("ds_read_b128 %0, %1 offset:%2" : "=&v"(r) : "v"(a), "i"(OFF) : "memory"); return r; }
__device__ __forceinline__ void stepA(f32x16& n0, f32x16& n1, const u16* Ks, const bf16x8* qr, int r32, int hi, f32x16& p0, f32x16& p1, float& lA,
                                      u32x4& w0, u32x4& w1, u32x4& w2, VFrag& vf, int vb) {
  const int swb = ((r32 & 15) << 4) ^ (hi * 16), kl = (int)(uintptr_t)Ks + r32 * 256;
  int kbm[8];
#pragma unroll
  for (int d = 0; d < 8; ++d) kbm[d] = kl + (swb ^ (d * 32));
#define KR(X, d0, B) X = kread<(B) * 8192>(kbm[d0])
#define GA(i, WN, MF, RD, CV) do { asm volatile("s_waitcnt lgkmcnt(" #WN ")" ::: "memory"); __builtin_amdgcn_s_setprio(1); SBAR(); MF; SBAR(); __builtin_amdgcn_s_setprio(0); RD; { float e_ = __builtin_amdgcn_exp2f(p1[i]); PIN(e_); p1[i] = e_; } \
    lA += ((i) == 0 ? p0[15] : p1[(i) == 0 ? 0 : (i) - 1]); CV; PIN(lA); SBAR(); } while (0)
  bf16x8 x0, x1, x2, x3, y0, y1, y2, y3;
  KR(x0, 0, 0); KR(x1, 0, 1); KR(x2, 1, 0); KR(x3, 1, 1); SBAR();
  GA(0,  3, n0 = MF32(x0, qr[0], f32x16{}), KR(y0, 2, 0), { w0[0] = cvtpk(p0[0], p0[1]);   PIN(w0); });
  GA(1,  3, n1 = MF32(x1, qr[0], f32x16{}), KR(y1, 2, 1), { w0[1] = cvtpk(p0[2], p0[3]);   PIN(w0); });
  GA(2,  3, n0 = MF32(x2, qr[1], n0),       KR(y2, 3, 0), { w0[2] = cvtpk(p0[4], p0[5]);   PIN(w0); });
  GA(3,  3, n1 = MF32(x3, qr[1], n1),       KR(y3, 3, 1), { w0[3] = cvtpk(p0[6], p0[7]);   PIN(w0); });
  GA(4,  3, n0 = MF32(y0, qr[2], n0),       KR(x0, 4, 0), { w1[0] = cvtpk(p0[8], p0[9]);   PIN(w1); });
  GA(5,  3, n1 = MF32(y1, qr[2], n1),       KR(x1, 4, 1), { w1[1] = cvtpk(p0[10], p0[11]); PIN(w1); });
  GA(6,  3, n0 = MF32(y2, qr[3], n0),       KR(x2, 5, 0), { w1[2] = cvtpk(p0[12], p0[13]); PIN(w1); });
  GA(7,  3, n1 = MF32(y3, qr[3], n1),       KR(x3, 5, 1), { w1[3] = cvtpk(p0[14], p0[15]); PIN(w1); });
  GA(8,  3, n0 = MF32(x0, qr[4], n0),       KR(y0, 6, 0), { w2[0] = cvtpk(p1[0], p1[1]);   PIN(w2); });
  GA(9,  3, n1 = MF32(x1, qr[4], n1),       KR(y1, 6, 1), { w2[1] = cvtpk(p1[2], p1[3]);   PIN(w2); });
  GA(10, 3, n0 = MF32(x2, qr[5], n0),       KR(y2, 7, 0), { w2[2] = cvtpk(p1[4], p1[5]);   PIN(w2); });
  GA(11, 3, n1 = MF32(x3, qr[5], n1),       KR(y3, 7, 1), { w2[3] = cvtpk(p1[6], p1[7]);   PIN(w2); });
  GA(12, 3, n0 = MF32(y0, qr[6], n0),       VF_RDF(vf, 0, 0, vb), {});
  GA(13, 4, n1 = MF32(y1, qr[6], n1),       VF_RDF(vf, 1, 0, vb), {});
  GA(14, 5, n0 = MF32(y2, qr[7], n0),       VF_RDF(vf, 2, 0, vb), {});
  GA(15, 6, n1 = MF32(y3, qr[7], n1),       VF_RDF(vf, 3, 0, vb), {});
#undef KR
#undef GA
}
struct DmaCtx { const u16* Kh; const u16* Vh; int kgo0, kgo1, vgo0, vgo1; LAS unsigned char* ldsa; int wid, s, NT; };
#define DMAP(base, t, go, ring_off, img, i) __builtin_amdgcn_global_load_lds((const unsigned*)((base) + (size_t)(t) * (KVBLK * LDK) + (go)), \
    (LAS unsigned*)(dc.ldsa + (ring_off) + ((t) & 3) * (img) + dc.wid * 1024 + (i) * 8192), 16, 0, 0)
template <bool SHIFT, bool DMA> __device__ __forceinline__ void stepB(f32x16* o, int vb, u32x4 w0, u32x4 w1, u32x4 w2, f32x16& p1, VFrag& vf, f32x16& n0, f32x16& n1, float& lA, float& lB, float negBl2, const DmaCtx& dc) {
  const int tk3 = (dc.s + 3 < dc.NT) ? dc.s + 3 : dc.NT - 1;
  constexpr float C = SCALE * 1.4426950408889634f;
  VFrag vg; u32x4 w3;
#define FB(j) do { if constexpr (SHIFT) { float t0_ = fmaf(n0[j], C, negBl2), t1_ = fmaf(n1[j], C, negBl2); PIN(t0_); PIN(t1_); n0[j] = t0_; n1[j] = t1_; \
      if ((j) > 0) { float e_ = __builtin_amdgcn_exp2f(n0[(j) > 0 ? (j) - 1 : 0]); PIN(e_); n0[(j) > 0 ? (j) - 1 : 0] = e_; } if ((j) > 1) lB += n0[(j) > 1 ? (j) - 2 : 0]; } \
    else { float e_ = __builtin_amdgcn_exp2f(n0[j]); PIN(e_); n0[j] = e_; if ((j) > 0) lB += n0[(j) > 0 ? (j) - 1 : 0]; } PIN(lB); } while (0)
#define GB(j, WN, W, F, D0, RD, EXTRA) do { asm volatile("s_waitcnt lgkmcnt(" #WN ")" ::: "memory"); __builtin_amdgcn_s_setprio(1); SBAR(); o[D0] = MF32(BC8(W), VF_PKF(F, D0), o[D0]); SBAR(); __builtin_amdgcn_s_setprio(0); RD; FB(j); EXTRA; SBAR(); } while (0)
  GB(0,  6,w0, vf, 0, VF_RDF(vg, 0, 1, vb), { w3[0] = cvtpk(p1[8], p1[9]);   lA += p1[15]; PIN(w3); PIN(lA); });
  GB(1,  6,w0, vf, 1, VF_RDF(vg, 1, 1, vb), { w3[1] = cvtpk(p1[10], p1[11]); PIN(w3); });
  GB(2,  6,w0, vf, 2, VF_RDF(vg, 2, 1, vb), { w3[2] = cvtpk(p1[12], p1[13]); PIN(w3); });
  GB(3,  6,w0, vf, 3, VF_RDF(vg, 3, 1, vb), { w3[3] = cvtpk(p1[14], p1[15]); PIN(w3); });
  GB(4,  6,w1, vg, 0, VF_RDF(vf, 0, 2, vb), {});
  GB(5,  6,w1, vg, 1, VF_RDF(vf, 1, 2, vb), {});
  GB(6,  6,w1, vg, 2, VF_RDF(vf, 2, 2, vb), {});
  GB(7,  6,w1, vg, 3, VF_RDF(vf, 3, 2, vb), {});
  GB(8,  6,w2, vf, 0, VF_RDF(vg, 0, 3, vb), { if constexpr (DMA) DMAP(dc.Kh, dc.s + 2, dc.kgo0, RING * SHM_V, SHM_K, 0); });
  GB(9,  6,w2, vf, 1, VF_RDF(vg, 1, 3, vb), { if constexpr (DMA) DMAP(dc.Kh, dc.s + 2, dc.kgo1, RING * SHM_V, SHM_K, 1); });
  GB(10, 6,w2, vf, 2, VF_RDF(vg, 2, 3, vb), { if constexpr (DMA) DMAP(dc.Vh, dc.s + 1, dc.vgo0, 0, SHM_V, 0); });
  GB(11, 6,w2, vf, 3, VF_RDF(vg, 3, 3, vb), { if constexpr (DMA) DMAP(dc.Vh, dc.s + 1, dc.vgo1, 0, SHM_V, 1); });
  GB(12, 6,w3, vg, 0, {}, { if constexpr (DMA) DMAP(dc.Kh, tk3, dc.kgo0, RING * SHM_V, SHM_K, 0); });
  GB(13, 4,w3, vg, 1, {}, { if constexpr (DMA) DMAP(dc.Kh, tk3, dc.kgo1, RING * SHM_V, SHM_K, 1); });
  GB(14, 2,w3, vg, 2, {}, { if constexpr (DMA) DMAP(dc.Vh, dc.s + 2, dc.vgo0, 0, SHM_V, 0); });
  GB(15, 0,w3, vg, 3, {}, { if constexpr (DMA) DMAP(dc.Vh, dc.s + 2, dc.vgo1, 0, SHM_V, 1); });
  if constexpr (SHIFT) { float e_ = __builtin_amdgcn_exp2f(n0[15]); PIN(e_); n0[15] = e_; lB += n0[14]; }
#undef FB
#undef GB
}
#undef DMAP
__device__ __forceinline__ void finish_last(f32x16& p0, f32x16& p1, float& l, bf16x8& pa0, bf16x8& pa1, bf16x8& pa2, bf16x8& pa3) {
  for (int r = 0; r < 16; ++r) p1[r] = __builtin_amdgcn_exp2f(p1[r]);
  float ps = p0[15]; for (int r = 0; r < 16; ++r) ps += p1[r];
  l += ps;
  PK4F(p0, 0, pa0); PK4F(p0, 8, pa1); PK4F(p1, 0, pa2); PK4F(p1, 8, pa3);
}
template <bool SHIFT> __device__ __forceinline__ void attn_unit(u16* Qb, const u16* __restrict__ Kh, const u16* __restrict__ Vh, const float* __restrict__ qnw, int pos0, int seq, float negBl2, char* lds) {
  int tid = threadIdx.x; asm volatile("" : "+v"(tid));
  const int wid = __builtin_amdgcn_readfirstlane(tid >> 6), lane = tid & 63, r32 = lane & 31, hi = lane >> 5;
  u16* V_lds = (u16*)lds; u16* K_lds = (u16*)(lds + RING * SHM_V);
  float* ws = (float*)(lds + WS_OFF) + wid * 64; float* li_l = ws;
  float l_reg = 0; f32x16 o[4] = {}; bf16x8 qr[8];
  int kgo[2], vgo[2];
#pragma unroll
  for (int i = 0; i < 2; ++i) { const int a = i * 8192 + tid * 16;
    { const int row = a >> 8, cb = (a & 255) ^ ((row & 15) << 4); kgo[i] = row * LDK + (cb >> 1); }
    { const int t = a >> 9, within = (a & 511) >> 1, kk = ((t >> 2) << 3) | (within >> 5), c = (t & 3) * 32 + (within & 31); vgo[i] = kk * LDK + c; } }
  LAS unsigned char* ldsa = (LAS unsigned char*)lds;
#define DMA_K(t) do { const u16* kt_ = Kh + (size_t)(t) * (KVBLK * LDK); LAS unsigned char* d_ = ldsa + RING * SHM_V + ((t) & 3) * SHM_K + wid * 1024; \
    __builtin_amdgcn_global_load_lds((const unsigned*)(kt_ + kgo[0]), (LAS unsigned*)d_, 16, 0, 0); __builtin_amdgcn_global_load_lds((const unsigned*)(kt_ + kgo[1]), (LAS unsigned*)(d_ + 8192), 16, 0, 0); } while (0)
#define DMA_V(t) do { const u16* vt_ = Vh + (size_t)(t) * (KVBLK * LDK); LAS unsigned char* d_ = ldsa + ((t) & 3) * SHM_V + wid * 1024; \
    __builtin_amdgcn_global_load_lds((const unsigned*)(vt_ + vgo[0]), (LAS unsigned*)d_, 16, 0, 0); __builtin_amdgcn_global_load_lds((const unsigned*)(vt_ + vgo[1]), (LAS unsigned*)(d_ + 8192), 16, 0, 0); } while (0)
#define LANDED() do { asm volatile("s_waitcnt vmcnt(0)" ::: "memory"); __syncthreads(); } while (0)
#define KSL(t) ((u16*)((char*)K_lds + ((t) & 3) * SHM_K))
#define VSL(t) (vb0 + ((t) & 3) * (int)SHM_V)
  DMA_K(0); DMA_V(0); DMA_K(1); DMA_K(2); DMA_V(1);
  {
    int hl = hi; asm volatile("" : "+v"(hl));
    const u16* Qw = Qb + (long)(wid * QBLK + r32) * LDQ + hi * 8;
    u32x4 raw[8];
#pragma unroll
    for (int d0 = 0; d0 < 8; ++d0) raw[d0] = *reinterpret_cast<const u32x4*>(Qw + d0 * 16);
    float ss = 0.f;
#pragma unroll
    for (int d0 = 0; d0 < 8; ++d0)
#pragma unroll
      for (int e = 0; e < 4; ++e) { const float a = bflo(raw[d0][e]), b = bfhi(raw[d0][e]); ss += a * a + b * b; }
    { auto rr = __builtin_amdgcn_permlane32_swap(__float_as_uint(ss), __float_as_uint(ss), false, false); ss = __uint_as_float(rr[0]) + __uint_as_float(rr[1]); }
    const float rstd = (SHIFT ? 1.0f : SCALE * 1.4426950408889634f) / sqrtf(ss * (1.0f / 128.0f) + EPS);
    const int pos = pos0 + wid * QBLK + r32; const float prow = (float)(pos >> 6), pcol = (float)(pos & 63);
#pragma unroll
    for (int d0 = 0; d0 < 8; ++d0) {
      const f32x4 w0 = *reinterpret_cast<const f32x4*>(qnw + d0 * 16 + hl * 8), w1 = *reinterpret_cast<const f32x4*>(qnw + d0 * 16 + hl * 8 + 4);
      const float wv[8] = {w0[0], w0[1], w0[2], w0[3], w1[0], w1[1], w1[2], w1[3]};
      u32x4 wq;
#pragma unroll
      for (int e = 0; e < 4; ++e) {
        const int fi = (d0 & 3) * 8 + hl * 4 + e;
        const float inv = exp2f(-(float)fi * 0.41524101186092029f);
        const float ang = (d0 < 4 ? prow : pcol) * inv; const float sn = __sinf(ang), cs = __cosf(ang);
        const float x0 = bflo(raw[d0][e]) * rstd * wv[2 * e], x1 = bfhi(raw[d0][e]) * rstd * wv[2 * e + 1];
        wq[e] = cvtpk(x0 * cs - x1 * sn, x0 * sn + x1 * cs); }
      qr[d0] = *reinterpret_cast<bf16x8*>(&wq); }
  }
  const int vb0 = (int)(uintptr_t)V_lds + v_rd_base(lane);
  f32x16 pA0, pA1, pB0, pB1; bf16x8 pa0, pa1, pa2, pa3; const int NT = seq / KVBLK;
  LANDED();
  qkt(pA0, pA1, KSL(0), qr, r32, hi); partialSM<SHIFT>(pA0, pA1, negBl2);
  float lA = 0.f, lB = 0.f; u32x4 w0, w1, w2;
#pragma unroll
  for (int r = 0; r < 15; ++r) lA += pA0[r];
  VFrag vf;
  DmaCtx dc{Kh, Vh, kgo[0], kgo[1], vgo[0], vgo[1], ldsa, wid, 0, NT};
  for (int s = 1; s + 1 < NT; s += 2) {
    LANDED();
    dc.s = s;
    SBAR(); stepA(pB0, pB1, KSL(s), qr, r32, hi, pA0, pA1, lA, w0, w1, w2, vf, VSL(s - 1)); SBAR();
    stepB<SHIFT, true>(o, VSL(s - 1), w0, w1, w2, pA1, vf, pB0, pB1, lA, lB, negBl2, dc);
    SBAR(); stepA(pA0, pA1, KSL(s + 1), qr, r32, hi, pB0, pB1, lA, w0, w1, w2, vf, VSL(s)); SBAR();
    stepB<SHIFT, false>(o, VSL(s), w0, w1, w2, pB1, vf, pA0, pA1, lA, lB, negBl2, dc);
  }
  LANDED();
  SBAR(); stepA(pB0, pB1, KSL(NT - 1), qr, r32, hi, pA0, pA1, lA, w0, w1, w2, vf, VSL(NT - 2)); SBAR();
  stepB<SHIFT, false>(o, VSL(NT - 2), w0, w1, w2, pA1, vf, pB0, pB1, lA, lB, negBl2, dc);
  l_reg = lA + lB;
  finish_last(pB0, pB1, l_reg, pa0, pa1, pa2, pa3); SBAR();
  pv_d0(o, VSL(NT - 1), pa0, pa1, pa2, pa3);
  { auto rr = __builtin_amdgcn_permlane32_swap(__float_as_uint(l_reg), __float_as_uint(l_reg), false, false); l_reg = __uint_as_float(rr[0]) + __uint_as_float(rr[1]); }
  if (hi == 0) li_l[r32] = l_reg; asm volatile("s_waitcnt lgkmcnt(0)" ::: "memory");
  float rli[16];
#pragma unroll
  for (int r = 0; r < 16; ++r) rli[r] = __builtin_amdgcn_rcpf(li_l[crow(r, hi)]);
  u16* Ow = Qb + (long)(wid * QBLK) * LDQ;
#pragma unroll
  for (int r = 0; r < 16; ++r) { const int oo = crow(r, hi) * LDQ + r32;
    for (int d0 = 0; d0 < 4; ++d0) Ow[oo + d0 * 32] = (u16)(cvtpk(o[d0][r] * rli[r], 0.f) & 0xffffu); }
  __syncthreads();
#undef DMA_K
#undef DMA_V
#undef LANDED
#undef KSL
#undef VSL
}
#undef PIN
#undef MF32
#undef VF_RD2
#undef VF_PK
#undef VF_RDF
#undef VF_PKF
#undef BC8
#undef PK4F
#undef KSWZ
#undef SBAR
}

namespace hg {
typedef short bf16x8 __attribute__((ext_vector_type(8)));
typedef float f32x4 __attribute__((ext_vector_type(4)));
typedef unsigned u32x4 __attribute__((ext_vector_type(4)));
constexpr int L_TOT = 0, L_VT = 8192, L_QT = 24576, L_QB = 40960, L_KT = 57344, L_P = 122880;
constexpr int L_RED = 0, L_RSTD = 2048, L_OUT = L_KT;
__device__ __forceinline__ int sidx(int gc, int h, int dir) { return (gc * 16 + h) * 2 + dir; }
__device__ __forceinline__ int off256(int row, int chunk) { return row * 256 + ((chunk ^ (row & 7)) << 4); }
__device__ __forceinline__ int off128(int row, int chunk) { return row * 128 + ((chunk ^ (row & 7)) << 4); }
__device__ __forceinline__ float h2f_lo(unsigned w) { f16x2_t h = __builtin_bit_cast(f16x2_t, w); return (float)h[0]; }
__device__ __forceinline__ float h2f_hi(unsigned w) { f16x2_t h = __builtin_bit_cast(f16x2_t, w); return (float)h[1]; }

__device__ __forceinline__ void gate_local(const unsigned (&zr)[8], const float* lbp, int cp, int tg, int dir, LAS unsigned char* lds, float (&kk)[8][2], float (&p)[8][2]) {
    float oml[2];
#pragma unroll
    for (int e = 0; e < 2; ++e) oml[e] = 1.0f - sigm(lbp[2 * cp + e] - lbp[HGW + 2 * cp + e]);
    float lf[8][2];
#pragma unroll
    for (int j = 0; j < 8; ++j)
#pragma unroll
        for (int e = 0; e < 2; ++e) { const float z = e ? h2f_hi(zr[j]) : h2f_lo(zr[j]); const float k1 = oml[e] * __builtin_amdgcn_rcpf(1.0f + __expf(z)); kk[j][e] = k1; lf[j][e] = __logf(1.0f - k1); }
#pragma unroll
    for (int e = 0; e < 2; ++e) { float run = 0.f;
        if (dir == 0) {
#pragma unroll
            for (int j = 0; j < 8; ++j) { run += lf[j][e]; p[j][e] = run; } }
        else {
#pragma unroll
            for (int j = 7; j >= 0; --j) { run += lf[j][e]; p[j][e] = run; } }
        ((LAS float*)(lds + L_TOT))[(dir * 8 + tg) * 128 + 2 * cp + e] = run; }
}
__device__ __forceinline__ void gate_global(int cp, int tg, int dir, LAS unsigned char* lds, float (&p)[8][2], float (&sub)[4][2], float (&R)[2], float (&Tot)[2]) {
    const LAS float* T = (const LAS float*)(lds + L_TOT) + dir * 8 * 128 + 2 * cp;
    float t8[8][2];
#pragma unroll
    for (int g = 0; g < 8; ++g) { const f32x2_t v = *(const LAS f32x2_t*)(T + g * 128); t8[g][0] = v.x; t8[g][1] = v.y; }
    const int I = tg >> 1; const bool second = dir ? ((tg & 1) == 0) : ((tg & 1) == 1);
#pragma unroll
    for (int e = 0; e < 2; ++e) {
#pragma unroll
        for (int i2 = 0; i2 < 4; ++i2) sub[i2][e] = t8[2 * i2][e] + t8[2 * i2 + 1][e];
        float partner = 0.f;
#pragma unroll
        for (int g = 0; g < 8; ++g) partner = (g == (tg ^ 1)) ? t8[g][e] : partner;
        const float add = second ? partner : 0.f;
#pragma unroll
        for (int j = 0; j < 8; ++j) p[j][e] += add;
        float r = 0.f;
#pragma unroll
        for (int i2 = 0; i2 < 4; ++i2) { const bool before = dir ? (i2 > I) : (i2 < I); r += before ? sub[i2][e] : 0.f; }
        R[e] = r; Tot[e] = (sub[0][e] + sub[1][e]) + (sub[2][e] + sub[3][e]); }
}

struct APre { unsigned zf[8], zb[8]; };
__device__ __forceinline__ void pass_a_load(APre& p, int gc, int h, const u16* ZF, const u16* ZB, int tid) {
    const int cp = tid & 63, tg = __builtin_amdgcn_readfirstlane(tid >> 6);
    const size_t row0 = (size_t)(gc >= 128 ? T0 + (gc - 128) * 64 : gc * 64);
    const size_t rowoff = (row0 + 8 * tg) * HGW + h * 128 + 2 * cp;
#pragma unroll
    for (int j = 0; j < 8; ++j) { p.zf[j] = *(const unsigned*)(ZF + rowoff + (size_t)j * HGW); p.zb[j] = *(const unsigned*)(ZB + rowoff + (size_t)j * HGW); }
}
__device__ __forceinline__ void pass_a_item(APre& pre, int ngc, int nh, bool has_next, int gc, int h, const u16* ZF, const u16* ZB, const u16* HI, const float* lbf, const float* lbb, u16* ST, float* DC, LAS unsigned char* lds, int tid) {
    const int cp = tid & 63, tg = __builtin_amdgcn_readfirstlane(tid >> 6), lane = tid & 63, fr = lane & 15, fq = lane >> 4, w = tg;
    const size_t row0 = (size_t)(gc >= 128 ? T0 + (gc - 128) * 64 : gc * 64);
    const size_t rowoff = (row0 + 8 * tg) * HGW + h * 128 + 2 * cp;
    unsigned vr[8];
#pragma unroll
    for (int j = 0; j < 8; ++j) vr[j] = *(const unsigned*)(HI + rowoff + (size_t)j * HGW);
    unsigned zf[8], zb[8];
#pragma unroll
    for (int j = 0; j < 8; ++j) { zf[j] = pre.zf[j]; zb[j] = pre.zb[j]; }
    float kk[2][8][2], p[2][8][2];
    gate_local(zf, lbf + h * 128, cp, tg, 0, lds, kk[0], p[0]);
    gate_local(zb, lbb + h * 128, cp, tg, 1, lds, kk[1], p[1]);
#pragma unroll
    for (int e = 0; e < 2; ++e) { u32x4 o;
        o.x = e ? ((vr[0] >> 16) | (vr[1] & 0xffff0000u)) : ((vr[0] & 0xffffu) | (vr[1] << 16)); o.y = e ? ((vr[2] >> 16) | (vr[3] & 0xffff0000u)) : ((vr[2] & 0xffffu) | (vr[3] << 16));
        o.z = e ? ((vr[4] >> 16) | (vr[5] & 0xffff0000u)) : ((vr[4] & 0xffffu) | (vr[5] << 16)); o.w = e ? ((vr[6] >> 16) | (vr[7] & 0xffff0000u)) : ((vr[6] & 0xffffu) | (vr[7] << 16));
        *(LAS u32x4*)(lds + L_VT + off128(2 * cp + e, tg)) = o; }
    __syncthreads();
#pragma unroll
    for (int dir = 0; dir < 2; ++dir) {
        float sub[4][2], R[2], Tot[2];
        gate_global(cp, tg, dir, lds, p[dir], sub, R, Tot);
#pragma unroll
        for (int e = 0; e < 2; ++e) { float k4[8];
#pragma unroll
            for (int j = 0; j < 8; ++j) k4[j] = kk[dir][j][e] * __expf(Tot[e] - R[e] - p[dir][j][e]);
            u32x4 o; o.x = pkbf(k4[0], k4[1]); o.y = pkbf(k4[2], k4[3]); o.z = pkbf(k4[4], k4[5]); o.w = pkbf(k4[6], k4[7]);
            *(LAS u32x4*)(lds + L_KT + dir * 16384 + off128(2 * cp + e, tg)) = o;
            if (tg == 0) DC[(size_t)sidx(gc, h, dir) * 128 + 2 * cp + e] = __expf(Tot[e]); }
    }
    __syncthreads();
    if (has_next) pass_a_load(pre, ngc, nh, ZF, ZB, tid);
#pragma unroll
    for (int dir = 0; dir < 2; ++dir) {
        f32x4 acc[8];
#pragma unroll
        for (int n = 0; n < 8; ++n) acc[n] = (f32x4){0.f, 0.f, 0.f, 0.f};
#pragma unroll
        for (int ks = 0; ks < 2; ++ks) { const bf16x8 a = *(const LAS bf16x8*)(lds + L_KT + dir * 16384 + off128(16 * w + fr, 4 * ks + fq));
#pragma unroll
            for (int n = 0; n < 8; ++n) { const bf16x8 b = *(const LAS bf16x8*)(lds + L_VT + off128(16 * n + fr, 4 * ks + fq)); acc[n] = __builtin_amdgcn_mfma_f32_16x16x32_bf16(a, b, acc[n], 0, 0, 0); } }
        u16* st = ST + (size_t)sidx(gc, h, dir) * 16384 + 16 * w + 4 * fq;
#pragma unroll
        for (int n = 0; n < 8; ++n) { u32x2_t o; o.x = pkbf(acc[n][0], acc[n][1]); o.y = pkbf(acc[n][2], acc[n][3]); *(u32x2_t*)(st + (16 * n + fr) * 128) = o; }
    }
    __syncthreads();
}

__device__ __forceinline__ void pass_b_item(int item, u16* ST, const float* DC, int tid) {
    const int chain = item >> 2, quarter = item & 3, seq = (chain >> 5) ^ 1, dir = (chain >> 4) & 1, h = chain & 15;
    const int n = seq ? 256 : 128, gc0 = seq ? 128 : 0, e16 = quarter * 512 + tid, k0 = (e16 & 15) * 8;
    float S[8];
#pragma unroll
    for (int i = 0; i < 8; ++i) S[i] = 0.f;
    for (int s0 = 0; s0 < n; s0 += 4) {
        u32x4 d[4]; f32x4 da[4], db[4]; u32x4* sp[4];
#pragma unroll
        for (int u = 0; u < 4; ++u) { const int c = dir ? n - 1 - (s0 + u) : s0 + u; const size_t si = (size_t)sidx(gc0 + c, h, dir);
            sp[u] = (u32x4*)(ST + si * 16384) + e16; d[u] = *sp[u]; da[u] = *(const f32x4*)(DC + si * 128 + k0); db[u] = *(const f32x4*)(DC + si * 128 + k0 + 4); }
#pragma unroll
        for (int u = 0; u < 4; ++u) {
            u32x4 o; o.x = pkbf(S[0], S[1]); o.y = pkbf(S[2], S[3]); o.z = pkbf(S[4], S[5]); o.w = pkbf(S[6], S[7]); *sp[u] = o;
            S[0] = da[u][0] * S[0] + bflo(d[u].x); S[1] = da[u][1] * S[1] + bfhi(d[u].x); S[2] = da[u][2] * S[2] + bflo(d[u].y); S[3] = da[u][3] * S[3] + bfhi(d[u].y);
            S[4] = db[u][0] * S[4] + bflo(d[u].z); S[5] = db[u][1] * S[5] + bfhi(d[u].z); S[6] = db[u][2] * S[6] + bflo(d[u].w); S[7] = db[u][3] * S[7] + bfhi(d[u].w); }
    }
}

struct CPre { unsigned zf[8]; };
__device__ __forceinline__ void pass_c_load(CPre& p, int gc, int h, const u16* ZF, int tid) {
    const int cp = tid & 63, tg = __builtin_amdgcn_readfirstlane(tid >> 6);
    const size_t row0 = (size_t)(gc >= 128 ? T0 + (gc - 128) * 64 : gc * 64);
    const size_t rowoff = (row0 + 8 * tg) * HGW + h * 128 + 2 * cp;
#pragma unroll
    for (int j = 0; j < 8; ++j) p.zf[j] = *(const unsigned*)(ZF + rowoff + (size_t)j * HGW);
}
__device__ __forceinline__ void pass_c_item(CPre& pre, int ngc, int nh, bool has_next, int gc, int h, u16* HQ, const u16* ZF, const u16* ZB, const u16* HI, const u16* HOG, const float* lbf, const float* lbb, const float* hgw,
                                            const u16* ST, LAS unsigned char* lds, int tid) {
    const int cp = tid & 63, tg = __builtin_amdgcn_readfirstlane(tid >> 6), lane = tid & 63, fr = lane & 15, fq = lane >> 4, w = tg;
    const size_t row0 = (size_t)(gc >= 128 ? T0 + (gc - 128) * 64 : gc * 64);
    const size_t rowoff = (row0 + 8 * tg) * HGW + h * 128 + 2 * cp;
    unsigned qr[8], vr[8], zz[2][8];
#pragma unroll
    for (int j = 0; j < 8; ++j) { zz[0][j] = pre.zf[j]; vr[j] = *(const unsigned*)(HI + rowoff + (size_t)j * HGW); qr[j] = *(const unsigned*)(HQ + rowoff + (size_t)j * HGW); zz[1][j] = *(const unsigned*)(ZB + rowoff + (size_t)j * HGW); }
    f32x4 oacc[4];
#pragma unroll
    for (int mi = 0; mi < 4; ++mi) oacc[mi] = (f32x4){0.f, 0.f, 0.f, 0.f};
#pragma unroll 1
    for (int dir = 0; dir < 2; ++dir) {
        bf16x8 sf[4];
#pragma unroll
        for (int ks = 0; ks < 4; ++ks) sf[ks] = *(const bf16x8*)(ST + (size_t)sidx(gc, h, dir) * 16384 + (16 * w + fr) * 128 + 32 * ks + 8 * fq);
        float kk[8][2], p[8][2];
        if (dir == 0) gate_local(zz[0], lbf + h * 128, cp, tg, 0, lds, kk, p); else gate_local(zz[1], lbb + h * 128, cp, tg, 1, lds, kk, p);
        if (dir == 0) {
#pragma unroll
    for (int e = 0; e < 2; ++e) { u32x4 o;
        o.x = e ? ((vr[0] >> 16) | (vr[1] & 0xffff0000u)) : ((vr[0] & 0xffffu) | (vr[1] << 16)); o.y = e ? ((vr[2] >> 16) | (vr[3] & 0xffff0000u)) : ((vr[2] & 0xffffu) | (vr[3] << 16));
        o.z = e ? ((vr[4] >> 16) | (vr[5] & 0xffff0000u)) : ((vr[4] & 0xffffu) | (vr[5] << 16)); o.w = e ? ((vr[6] >> 16) | (vr[7] & 0xffff0000u)) : ((vr[6] & 0xffffu) | (vr[7] << 16));
        *(LAS u32x4*)(lds + L_VT + off128(2 * cp + e, tg)) = o; }
        }
        __syncthreads();
        float sub[4][2], R[2], Tot[2];
        gate_global(cp, tg, dir, lds, p, sub, R, Tot);
        const int I = tg >> 1;
        float eR[2], F[4][2];
#pragma unroll
        for (int e = 0; e < 2; ++e) { eR[e] = __expf(R[e]);
#pragma unroll
            for (int Ir = 0; Ir < 4; ++Ir) { float d = 0.f;
#pragma unroll
                for (int i2 = 0; i2 < 4; ++i2) { const bool between = dir ? (i2 <= I && i2 > Ir) : (i2 >= I && i2 < Ir); d += between ? sub[i2][e] : 0.f; }
                const bool after = dir ? (Ir < I) : (Ir > I);
                F[Ir][e] = (Ir == I) ? 1.0f : (after ? __expf(d) : 0.0f); } }
#pragma unroll
        for (int j = 0; j < 8; ++j) { const int i = 8 * tg + j;
            const float q0 = bflo(qr[j]), q1 = bfhi(qr[j]);
            const float ea0 = __expf(p[j][0]), ea1 = __expf(p[j][1]);
            const float qt0 = q0 * ea0, qt1 = q1 * ea1;
            *(LAS unsigned*)(lds + L_QT + off256(i, cp >> 2) + (cp & 3) * 4) = pkbf(qt0, qt1);
            *(LAS unsigned*)(lds + L_QB + off256(i, cp >> 2) + (cp & 3) * 4) = pkbf(qt0 * eR[0], qt1 * eR[1]);
            const float kd0 = kk[j][0] * __expf(fminf(-p[j][0], 80.f)), kd1 = kk[j][1] * __expf(fminf(-p[j][1], 80.f));
#pragma unroll
            for (int Ir = 0; Ir < 4; ++Ir) *(LAS unsigned*)(lds + L_KT + Ir * 16384 + off256(i, cp >> 2) + (cp & 3) * 4) = pkbf(kd0 * F[Ir][0], kd1 * F[Ir][1]); }
        __syncthreads();
        { const int Ib = w >> 1;
#pragma unroll
          for (int jj = 0; jj < 2; ++jj) { const int J = 2 * (w & 1) + jj; f32x4 sc = (f32x4){0.f, 0.f, 0.f, 0.f};
#pragma unroll
            for (int ks = 0; ks < 4; ++ks) { const bf16x8 a = *(const LAS bf16x8*)(lds + L_QT + off256(16 * Ib + fr, 4 * ks + fq));
                const bf16x8 b = *(const LAS bf16x8*)(lds + L_KT + Ib * 16384 + off256(16 * J + fr, 4 * ks + fq)); sc = __builtin_amdgcn_mfma_f32_16x16x32_bf16(a, b, sc, 0, 0, 0); }
#pragma unroll
            for (int r = 0; r < 4; ++r) { const int il = 4 * fq + r; float v = sc[r];
                if (J == Ib) { const bool keep = dir ? (fr >= il) : (fr <= il); v = keep ? v : 0.f; }
                const int row = 16 * Ib + il, col = 16 * J + fr;
                *(LAS u16*)(lds + L_P + off128(row, col >> 3) + (col & 7) * 2) = (u16)(pkbf(v, 0.f) & 0xffffu); } } }
        __syncthreads();
#pragma unroll
        for (int ks = 0; ks < 4; ++ks) { const bf16x8 b = sf[ks];
#pragma unroll
            for (int mi = 0; mi < 4; ++mi) { const bf16x8 a = *(const LAS bf16x8*)(lds + L_QB + off256(16 * mi + fr, 4 * ks + fq)); oacc[mi] = __builtin_amdgcn_mfma_f32_16x16x32_bf16(a, b, oacc[mi], 0, 0, 0); } }
#pragma unroll
        for (int ks = 0; ks < 2; ++ks) { const bf16x8 b = *(const LAS bf16x8*)(lds + L_VT + off128(16 * w + fr, 4 * ks + fq));
#pragma unroll
            for (int mi = 0; mi < 4; ++mi) { const bf16x8 a = *(const LAS bf16x8*)(lds + L_P + off128(16 * mi + fr, 4 * ks + fq)); oacc[mi] = __builtin_amdgcn_mfma_f32_16x16x32_bf16(a, b, oacc[mi], 0, 0, 0); } }
        __syncthreads();
    }
#pragma unroll
    for (int mi = 0; mi < 4; ++mi)
#pragma unroll
        for (int r = 0; r < 4; ++r) { float sq = oacc[mi][r] * oacc[mi][r];
            sq += __shfl_xor(sq, 1); sq += __shfl_xor(sq, 2); sq += __shfl_xor(sq, 4); sq += __shfl_xor(sq, 8);
            if (fr == 0) ((LAS float*)(lds + L_RED))[w * 64 + 16 * mi + 4 * fq + r] = sq; }
    __syncthreads();
    if (has_next) pass_c_load(pre, ngc, nh, ZF, tid);
    u32x4 hogr[2];
#pragma unroll
    for (int c2 = 0; c2 < 2; ++c2) { const int id = tid + 512 * c2; hogr[c2] = *(const u32x4*)(HOG + (row0 + (id >> 4)) * HGW + h * 128 + (id & 15) * 8); }
    if (tid < 64) { float t = 0.f;
#pragma unroll
        for (int ww = 0; ww < 8; ++ww) t += ((const LAS float*)(lds + L_RED))[ww * 64 + tid];
        ((LAS float*)(lds + L_RSTD))[tid] = 1.0f / sqrtf(t * (1.0f / 128.0f) + EPS); }
    __syncthreads();
    { const float wv = hgw[h * 128 + 16 * w + fr];
#pragma unroll
      for (int mi = 0; mi < 4; ++mi)
#pragma unroll
        for (int r = 0; r < 4; ++r) { const int i = 16 * mi + 4 * fq + r; ((LAS float*)(lds + L_OUT))[i * 128 + 16 * w + fr] = oacc[mi][r] * ((const LAS float*)(lds + L_RSTD))[i] * wv; } }
    __syncthreads();
#pragma unroll
    for (int c2 = 0; c2 < 2; ++c2) { const int id = tid + 512 * c2, i = id >> 4, vc = (id & 15) * 8;
        const f32x4 y0 = *(const LAS f32x4*)(lds + L_OUT + (i * 128 + vc) * 4), y1 = *(const LAS f32x4*)(lds + L_OUT + (i * 128 + vc + 4) * 4);
        const size_t go = (row0 + i) * HGW + h * 128 + vc; const u32x4 g = hogr[c2];
        u32x4 o; o.x = pkbf(y0[0] * bflo(g.x), y0[1] * bfhi(g.x)); o.y = pkbf(y0[2] * bflo(g.y), y0[3] * bfhi(g.y)); o.z = pkbf(y1[0] * bflo(g.z), y1[1] * bfhi(g.z)); o.w = pkbf(y1[2] * bflo(g.w), y1[3] * bfhi(g.w));
        *(u32x4*)(HQ + go) = o; }
    __syncthreads();
}
}

__device__ __forceinline__ void tr_item(const float* W, int K, int N, u16* WT, LAS float* scr, int item, int lane, bool gu) {
    const int nblk = N / 32, kb = item / nblk, nb = item % nblk, k0 = 64 * kb, n0 = 32 * nb;
    float wv_[32];
#pragma unroll
    for (int i = 0; i < 32; ++i) wv_[i] = W[(size_t)(k0 + 2 * i + (lane >> 5)) * N + n0 + (lane & 31)];
#pragma unroll
    for (int i = 0; i < 32; ++i) scr[(2 * i + (lane >> 5)) * 33 + (lane & 31)] = wv_[i];
    LDS_WAIT(); asm volatile("" ::: "memory");
    int r0 = n0;
    if (gu) { const int isu = n0 >= DFF ? 1 : 0, nn = n0 - isu * DFF; r0 = (nn >> 7) * 256 + isu * 128 + (nn & 127); }
    const int c = lane & 7;
#pragma unroll
    for (int j = 0; j < 4; ++j) { const int n = (lane >> 3) + 8 * j; const LAS float* s = scr + (8 * c) * 33 + n;
        v4u o; o.x = pkbf(s[0 * 33], s[1 * 33]); o.y = pkbf(s[2 * 33], s[3 * 33]); o.z = pkbf(s[4 * 33], s[5 * 33]); o.w = pkbf(s[6 * 33], s[7 * 33]);
        *(GAS v4u*)(WT + (size_t)(r0 + n) * K + k0 + 8 * c) = o; }
    LDS_WAIT(); asm volatile("" ::: "memory");
}
__device__ __forceinline__ void rms_row(const float* xrow, const float* w, u16* ob, float* of, int lane) {
    const f32x4* xr = (const f32x4*)xrow + lane; const f32x4* wr = (const f32x4*)w + lane;
    f32x4 v[16], wv[16]; float s = 0.f;
#pragma unroll
    for (int j = 0; j < 16; ++j) v[j] = xr[64 * j];
#pragma unroll
    for (int j = 0; j < 16; ++j) wv[j] = wr[64 * j];
#pragma unroll
    for (int j = 0; j < 16; ++j) s += (v[j].x * v[j].x + v[j].y * v[j].y) + (v[j].z * v[j].z + v[j].w * v[j].w);
    const float rstd = 1.0f / sqrtf(wave_sum(s) * (1.0f / DM) + EPS);
#pragma unroll
    for (int j = 0; j < 16; ++j) { const f32x4 o = (v[j] * rstd) * wv[j];
        if (ob) { u32x2_t p; p.x = pkbf(o.x, o.y); p.y = pkbf(o.z, o.w); ((u32x2_t*)ob)[lane + 64 * j] = p; }
        else ((f32x4*)of)[lane + 64 * j] = o; }
}
template <bool ADD> __device__ __forceinline__ void rms_row_b16(const u16* xrow, const u16* arow, const float* w, u16* ob, float* of, int lane) {
    const pg8::u32x4* xr = (const pg8::u32x4*)xrow + lane; const pg8::u32x4* ar = (const pg8::u32x4*)arow + lane; const f32x4* wr = (const f32x4*)w + 2 * lane;
    pg8::u32x4 v[8], va[8]; f32x4 wv[8][2]; float s = 0.f;
#pragma unroll
    for (int j = 0; j < 8; ++j) v[j] = xr[64 * j];
    if constexpr (ADD) {
#pragma unroll
        for (int j = 0; j < 8; ++j) va[j] = ar[64 * j]; }
#pragma unroll
    for (int j = 0; j < 8; ++j) { wv[j][0] = wr[128 * j]; wv[j][1] = wr[128 * j + 1]; }
    float f[8][8];
#pragma unroll
    for (int j = 0; j < 8; ++j) { f[j][0] = bflo(v[j].x); f[j][1] = bfhi(v[j].x); f[j][2] = bflo(v[j].y); f[j][3] = bfhi(v[j].y); f[j][4] = bflo(v[j].z); f[j][5] = bfhi(v[j].z); f[j][6] = bflo(v[j].w); f[j][7] = bfhi(v[j].w);
        if constexpr (ADD) { f[j][0] += bflo(va[j].x); f[j][1] += bfhi(va[j].x); f[j][2] += bflo(va[j].y); f[j][3] += bfhi(va[j].y); f[j][4] += bflo(va[j].z); f[j][5] += bfhi(va[j].z); f[j][6] += bflo(va[j].w); f[j][7] += bfhi(va[j].w); }
#pragma unroll
        for (int e = 0; e < 8; ++e) s += f[j][e] * f[j][e]; }
    const float rstd = 1.0f / sqrtf(wave_sum(s) * (1.0f / DM) + EPS);
#pragma unroll
    for (int j = 0; j < 8; ++j) { pg8::u32x4 o;
        if (!ob) { f32x4 a = {f[j][0], f[j][1], f[j][2], f[j][3]}, b = {f[j][4], f[j][5], f[j][6], f[j][7]};
            ((f32x4*)of)[2 * (lane + 64 * j)] = (a * rstd) * wv[j][0]; ((f32x4*)of)[2 * (lane + 64 * j) + 1] = (b * rstd) * wv[j][1]; continue; }
        o.x = pkbf(f[j][0] * rstd * wv[j][0].x, f[j][1] * rstd * wv[j][0].y); o.y = pkbf(f[j][2] * rstd * wv[j][0].z, f[j][3] * rstd * wv[j][0].w);
        o.z = pkbf(f[j][4] * rstd * wv[j][1].x, f[j][5] * rstd * wv[j][1].y); o.w = pkbf(f[j][6] * rstd * wv[j][1].z, f[j][7] * rstd * wv[j][1].w);
        ((pg8::u32x4*)ob)[lane + 64 * j] = o; }
}
__device__ __forceinline__ void k_norm_rope(u16* AK, const float* knw, int gw, int NGW, int lane) {
    const float inv = exp2f(-(float)(lane & 31) * 0.41524101186092029f);
    const float w0 = knw[2 * lane], w1 = knw[2 * lane + 1];
    for (int it = gw; it < M * 4; it += NGW) {
        const int m = it >> 2, kvh = it & 3; unsigned* p = (unsigned*)(AK + (size_t)m * KVW + kvh * 128) + lane;
        const unsigned raw = *p; const float a = bflo(raw), b = bfhi(raw);
        const float rstd = 1.0f / sqrtf(wave_sum(a * a + b * b) * (1.0f / 128.0f) + EPS);
        const int pos = m < T0 ? m : m - T0; const float ang = (lane < 32 ? (float)(pos >> 6) : (float)(pos & 63)) * inv;
        const float sn = __sinf(ang), cs = __cosf(ang), x0 = a * rstd * w0, x1 = b * rstd * w1;
        *p = pkbf(x0 * cs - x1 * sn, x0 * sn + x1 * cs);
    }
}
#ifndef GEMM_ALIGN
#define GEMM_ALIGN true
#endif
#ifndef GEMM_SP2
#define GEMM_SP2 true
#endif
#define GEMM_RUN(EPI) pg8::gemm_phase<EPI, pg8::StaticOrder, GEMM_ALIGN, GEMM_SP2>
constexpr int NPH = 12;
constexpr int I_GU = (DM / 64) * (2 * DFF / 32), I_DN = (DFF / 64) * (DM / 32), I_A = (HGW / 64) * (DM / 32), I_O = (DM / 64) * (DM / 32);
#ifndef I_GU_TAIL
#define I_GU_TAIL 28672
#endif
constexpr size_t WS_DC = WS_END, WS_NEED = WS_END + 8 * MiB;
struct Args { const float* in[16]; float* out; unsigned char* ws; int ph_lo, ph_hi; };
__global__ void __launch_bounds__(NWAVES * 64, 2) fwd_kernel(Args args) {
    extern __shared__ __attribute__((aligned(16))) unsigned char lds[];
    LAS unsigned char* ldsl = (LAS unsigned char*)lds;
    volatile LAS unsigned* MISC = (volatile LAS unsigned*)(ldsl + MISC_OFF);
    const int wave = __builtin_amdgcn_readfirstlane((int)threadIdx.x >> 6);
    const int G = gridDim.x; const int bx = blockIdx.x; const int vcu = (G % 8 == 0) ? (bx % 8) * (G / 8) + bx / 8 : bx;
    const int gw = vcu * NWAVES + wave, NGW = G * NWAVES;
    unsigned char* ws = args.ws; unsigned char* dob = (unsigned char*)args.out;
    float* const outp = args.out;
    gu32* ctl = (gu32*)(ws + WS_CTL);
    for (int u = threadIdx.x; u < (LDS_BYTES - 131072) / 4; u += NWAVES * 64) ((LAS unsigned*)(ldsl + 131072))[u] = 0u;
    __syncthreads();
    XcdBarrier bar = xcd_barrier_post((unsigned*)(ctl + CW_BAR), MISC + 8);
    const int lo = args.ph_lo, hi = args.ph_hi;
#define IN(k) (lo <= (k) && (k) < hi)
#define SEAM(k) do { if (IN((k) + 1)) xcd_barrier(bar); } while (0)
#define WIN_t ((u16*)(dol + DO_WIN))
#define Hn ((u16*)(dol + DO_H))
#define WA_t ((u16*)(wsl + WS_WA))
#define WB_t ((u16*)(wsl + WS_WB))
#define WOUT_t ((u16*)(wsl + WS_WOUT))
#define WGU_t ((u16*)(wsl + WS_WGU))
#define WDN_t ((u16*)(wsl + WS_WDN))
#define PHASE_PTRS size_t zof_ = 0; int zph = 0; int tidl_ = threadIdx.x; asm volatile("" : "+s"(zof_), "+s"(zph), "+v"(tidl_)); \
    unsigned char* wsl = ws + zof_; unsigned char* dol = dob + zof_;     \
    const int tid = tidl_, lane = tidl_ & 63; (void)tid; (void)lane
#define INP(k) (args.in[(k) + zph])

    if (IN(0)) { PHASE_PTRS;
        LAS float* scr = (LAS float*)(ldsl + wave * 16384);
        constexpr int I_IN = (DM / 64) * (INW / 32);
        constexpr int NITEMS = I_IN + 2 * I_A + I_O + (I_GU - I_GU_TAIL);
        for (int it = gw; it < NITEMS; it += NGW) {
            int r = it;
            if (r < I_IN) { tr_item(INP(3), DM, INW, WIN_t, scr, r, lane, false); continue; } r -= I_IN;
            if (r < I_A) { tr_item(INP(9), HGW, DM, WA_t, scr, r, lane, false); continue; } r -= I_A;
            if (r < I_A) { tr_item(INP(10), AW, DM, WB_t, scr, r, lane, false); continue; } r -= I_A;
            if (r < I_O) { tr_item(INP(11), DM, DM, WOUT_t, scr, r, lane, false); continue; } r -= I_O;
            tr_item(INP(13), DM, 2 * DFF, WGU_t, scr, I_GU_TAIL + r, lane, true);
        }
        for (int m = gw; m < M; m += NGW) rms_row(m < T0 ? INP(0) + (size_t)m * DM : INP(1) + (size_t)(m - T0) * DM, INP(2), Hn + (size_t)m * DM, nullptr, lane);
        SEAM(0);
    }
    if (IN(1)) { PHASE_PTRS;
        pg8::Gemm g{Hn, WIN_t, M, INW, DM}; pg8::StaticOrder S; S.init(M, INW, G, bx);
        EpiInProj E{wsl};
        GEMM_RUN(EpiInProj)(ldsl, g, S, E);
        { LAS float* scr = (LAS float*)(ldsl + wave * 16384); const bool split = (G == 256); const int w0 = split ? (bx - 128) * NWAVES + wave : bx * NWAVES + wave, nw = split ? 128 * NWAVES : G * NWAVES;
          int tl2_ = threadIdx.x; asm volatile("" : "+v"(tl2_));
          if (!split || bx >= 128) for (int it = w0; it < I_GU_TAIL; it += nw) tr_item(INP(13), DM, 2 * DFF, WGU_t, scr, it, tl2_ & 63, true); }
        SEAM(1);
    }
    if (IN(2)) { PHASE_PTRS;
        k_norm_rope((u16*)(wsl + WS_AK), INP(8), gw, NGW, lane);
        { hg::APre apre;
          if (vcu < 6144) hg::pass_a_load(apre, vcu >> 4, vcu & 15, (const u16*)(wsl + WS_ZF), (const u16*)(wsl + WS_ZB), tid);
          for (int it = vcu; it < 6144; it += G) { const int nit = it + G;
            hg::pass_a_item(apre, nit >> 4, nit & 15, nit < 6144, it >> 4, it & 15, (const u16*)(wsl + WS_ZF), (const u16*)(wsl + WS_ZB), (const u16*)(wsl + WS_HI), INP(4), INP(5), (u16*)dol, (float*)(wsl + WS_DC), ldsl, tid); } }
        SEAM(2);
    }
    if (IN(3)) { PHASE_PTRS;
        for (int item = vcu; item < 256; item += G) hg::pass_b_item(item, (u16*)dol, (const float*)(wsl + WS_DC), tid);
        SEAM(3);
    }
    if (IN(4)) { PHASE_PTRS;
        { hg::CPre cpre;
          if (vcu < 6144) hg::pass_c_load(cpre, vcu >> 4, vcu & 15, (const u16*)(wsl + WS_ZF), tid);
          for (int it = vcu; it < 6144; it += G) { const int nit = it + G;
            hg::pass_c_item(cpre, nit >> 4, nit & 15, nit < 6144, it >> 4, it & 15, (u16*)(wsl + WS_HQ), (const u16*)(wsl + WS_ZF), (const u16*)(wsl + WS_ZB), (const u16*)(wsl + WS_HI), (const u16*)(wsl + WS_HOG), INP(4), INP(5), INP(6), (const u16*)dol, ldsl, tid); } }
        float negBl2;
        { int tl_ = threadIdx.x; asm volatile("" : "+v"(tl_)); const int ln = tl_ & 63;
          const float* qw = INP(7); const float* kw = INP(8); float a = fmaxf(fabsf(qw[2 * ln]), fabsf(qw[2 * ln + 1])), k2 = fmaxf(fabsf(kw[2 * ln]), fabsf(kw[2 * ln + 1]));
#pragma unroll
          for (int o = 1; o < 64; o <<= 1) { a = fmaxf(a, __shfl_xor(a, o)); k2 = fmaxf(k2, __shfl_xor(k2, o)); }
          negBl2 = __uint_as_float(__builtin_amdgcn_readfirstlane(__float_as_uint(-1.4426950408889634f * 11.313708498984761f * a * k2))); }
        u16* AQ = (u16*)(wsl + WS_AQ); const u16* AK = (const u16*)(wsl + WS_AK); const u16* AV = (const u16*)(wsl + WS_AV);
#define ATT_UNITS(SH) for (int idx = vcu; idx < 1536; idx += G) {            \
            int seq, kvh, qh, qb; \
            if (idx < 1024) { seq = 1; kvh = idx >> 8; const int rem = idx & 255; qh = kvh * 4 + (rem >> 6); qb = rem & 63; } \
            else { const int j = idx - 1024; seq = 0; kvh = j >> 7; const int rem = j & 127; qh = kvh * 4 + (rem >> 5); qb = rem & 31; } \
            const size_t rowbase = seq ? T0 : 0; \
            att::attn_unit<SH>(AQ + (rowbase + (size_t)qb * 256) * AW + qh * 128, AK + rowbase * KVW + kvh * 128, AV + rowbase * KVW + kvh * 128, INP(7), qb * 256, seq ? T1 : T0, negBl2, (char*)lds); }
        if (negBl2 >= -60.0f) { ATT_UNITS(false) } else { ATT_UNITS(true) }
#undef ATT_UNITS
        SEAM(4);
    }
    if (IN(5)) { PHASE_PTRS;
        pg8::Gemm g{(const u16*)(wsl + WS_HQ), WA_t, M, DM, HGW}; pg8::StaticOrder S; S.init(M, DM, G, bx);
        EpiGate<false> E{(const u16*)(wsl + WS_GA), nullptr, (u16*)(wsl + WS_T)};
        GEMM_RUN(EpiGate<false>)(ldsl, g, S, E);
        if (IN(6)) { __builtin_amdgcn_fence(__ATOMIC_ACQUIRE, "agent"); asm volatile("s_waitcnt vmcnt(0)" ::: "memory"); __syncthreads(); }
    }
    if (IN(6)) { PHASE_PTRS;
        pg8::Gemm g{(const u16*)(wsl + WS_AQ), WB_t, M, DM, AW}; pg8::StaticOrder S; S.init(M, DM, G, bx);
        EpiGate<true> E{(const u16*)(wsl + WS_GB), (const u16*)(wsl + WS_T), (u16*)(wsl + WS_MERGED)};
        GEMM_RUN(EpiGate<true>)(ldsl, g, S, E);
        SEAM(6);
    }
    if (IN(7)) { PHASE_PTRS;
        pg8::Gemm g{(const u16*)(wsl + WS_MERGED), WOUT_t, M, DM, DM}; pg8::StaticOrder S; S.init(M, DM, G, bx);
        EpiResToB16 E{INP(0), INP(1), (u16*)(wsl + WS_X1B)};
        GEMM_RUN(EpiResToB16)(ldsl, g, S, E);
        SEAM(7);
    }
    if (IN(8)) { PHASE_PTRS;
        for (int m = gw; m < M; m += NGW) rms_row_b16<false>((const u16*)(wsl + WS_X1B) + (size_t)m * DM, nullptr, INP(12), (u16*)(wsl + WS_XN2) + (size_t)m * DM, nullptr, lane);
        SEAM(8);
    }
    if (IN(9)) { PHASE_PTRS;
        pg8::Gemm g{(const u16*)(wsl + WS_XN2), WGU_t, M, 2 * DFF, DM}; pg8::StaticOrder S; S.init(M, 2 * DFF, G, bx);
        EpiSwiGLU E{(u16*)(wsl + WS_ACT)};
        GEMM_RUN(EpiSwiGLU)(ldsl, g, S, E);
        { LAS float* scr = (LAS float*)(ldsl + wave * 16384); const bool split = (G == 256); const int w0 = split ? (bx - 64) * NWAVES + wave : bx * NWAVES + wave, nw = split ? 192 * NWAVES : G * NWAVES;
          int tl2_ = threadIdx.x; asm volatile("" : "+v"(tl2_));
          if (!split || bx >= 64) for (int it = w0; it < I_DN; it += nw) tr_item(INP(14), DFF, DM, WDN_t, scr, it, tl2_ & 63, false); }
        SEAM(9);
    }
    if (IN(10)) { PHASE_PTRS;
        pg8::Gemm g{(const u16*)(wsl + WS_ACT), WDN_t, M, DM, DFF}; pg8::StaticOrder S; S.init(M, DM, G, bx);
        EpiPlainB16 E{(u16*)(wsl + WS_X2B)};
        GEMM_RUN(EpiPlainB16)(ldsl, g, S, E);
        SEAM(10);
    }
    if (IN(11)) { PHASE_PTRS;
        for (int m = gw; m < M; m += NGW) rms_row_b16<true>((const u16*)(wsl + WS_X1B) + (size_t)m * DM, (const u16*)(wsl + WS_X2B) + (size_t)m * DM, INP(15), nullptr, outp + (size_t)m * DM, lane);
    }
#undef IN
#undef SEAM
#undef INP
#undef PHASE_PTRS
#undef WIN_t
#undef Hn
#undef WA_t
#undef WB_t
#undef WOUT_t
#undef WGU_t
#undef WDN_t
}

#ifndef MK_N_LAUNCHES
#define MK_N_LAUNCHES 1
#endif
extern "C" void kernel_launch(void* const* d_in, const int* in_sizes, int n_in, void* d_out, int out_size, void* d_ws, size_t ws_size, hipStream_t stream) {
    static int grid = 0;
    if (grid == 0) {
        if (n_in != 16 || in_sizes[0] != T0 * DM || in_sizes[1] != T1 * DM || out_size != M * DM || ws_size < WS_NEED) {
            fprintf(stderr, "kernel_launch: shape mismatch (n_in %d, out %d, ws %zu); nothing launched\n", n_in, out_size, ws_size); grid = -1; return; }
        int dev = 0, cus = 0, per_cu = 0;
        if (hipGetDevice(&dev) != hipSuccess || hipDeviceGetAttribute(&cus, hipDeviceAttributeMultiprocessorCount, dev) != hipSuccess) { grid = -1; return; }
        if (hipFuncSetAttribute((const void*)fwd_kernel, hipFuncAttributeMaxDynamicSharedMemorySize, LDS_BYTES) != hipSuccess) { fprintf(stderr, "kernel_launch: hipFuncSetAttribute failed\n"); grid = -1; return; }
        if (hipOccupancyMaxActiveBlocksPerMultiprocessor(&per_cu, (const void*)fwd_kernel, NWAVES * 64, LDS_BYTES) != hipSuccess || per_cu < 1) { fprintf(stderr, "kernel_launch: occupancy query says %d\n", per_cu); grid = -1; (void)hipGetLastError(); return; }
        grid = cus;
    }
    if (grid < 0) return;
    if (hipMemsetAsync((char*)d_ws + WS_CTL, 0, CTL_ZERO_BYTES, stream) != hipSuccess) return;
    Args a{};
    for (int i = 0; i < 16; ++i) a.in[i] = (const float*)d_in[i];
    a.out = (float*)d_out; a.ws = (unsigned char*)d_ws;
    if (MK_N_LAUNCHES == 1) { a.ph_lo = 0; a.ph_hi = NPH; hipLaunchKernelGGL(fwd_kernel, dim3(grid), dim3(NWAVES * 64), LDS_BYTES, stream, a); }
    else for (int p = 0; p < NPH; ++p) { a.ph_lo = p; a.ph_hi = p + 1; hipLaunchKernelGGL(fwd_kernel, dim3(grid), dim3(NWAVES * 64), LDS_BYTES, stream, a); }
    const hipError_t le = hipPeekAtLastError();
    if (le != hipSuccess) fprintf(stderr, "kernel_launch: launch failed: %s\n", hipGetErrorName(le));
}
```
